# Optimizing an MI355X kernel written in HIP

```python
import jax, jax.numpy as jnp
from jax import lax
import numpy as np

D_MODEL = 1024
BATCH = 8
SEQ = 2048
DEPTH = 2

RW_HEADS = 16
RW_HEAD_DIM = 64
RW_WIDTH = RW_HEADS * RW_HEAD_DIM
LORA_DECAY = 64
LORA_AAA = 64
LORA_VRES = 32
LORA_GATE = 160
CONV_WIDTH = 1024
CONV_K = 3
MEM_LEN = 256
MEM_HEADS = 4
MEM_HEAD_DIM = D_MODEL // MEM_HEADS
N_GROUPS = 4
EXPERTS_PER_GROUP = 4
N_EXPERTS = N_GROUPS * EXPERTS_PER_GROUP
TOP_K_IN_GROUP = 2
D_EXPERT = 512

RMS_EPS = 1e-6
LNX_EPS = 64e-5
L2_EPS = 1e-12

RW_COLS = 3 * RW_WIDTH + LORA_DECAY + LORA_AAA + LORA_GATE
CONV_COLS = 3 * CONV_WIDTH
GATE_COLS = 2 * D_MODEL
IN_COLS = RW_COLS + CONV_COLS + GATE_COLS

kernel_name = "hybrid_rwkv7_shortconv_memxattn_hmoe"


def rms_norm(x, g):
    xf = x.astype(jnp.float32)
    y = xf * lax.rsqrt(jnp.mean(xf * xf, axis=-1, keepdims=True) + RMS_EPS)
    return (y * g.astype(jnp.float32)).astype(x.dtype)


def token_shift(z):
    return jnp.pad(z, ((0, 0), (1, 0), (0, 0)))[:, :-1]


def shift_mix(z, mu):
    return z + (token_shift(z) - z) * mu


def wkv7_scan(r, w, k, v, a, b):
    bsz, _, h, n = r.shape
    seqs = tuple(jnp.moveaxis(t, 1, 0) for t in (r, w, k, v, a, b))

    def step(S, inp):
        r_t, w_t, k_t, v_t, a_t, b_t = inp
        sa = jnp.einsum('bhvk,bhk->bhv', S, a_t)
        S = (S * w_t[:, :, None, :] + sa[..., None] * b_t[:, :, None, :]
             + v_t[..., None] * k_t[:, :, None, :])
        y = jnp.einsum('bhvk,bhk->bhv', S, r_t)
        return S, y

    S0 = jnp.zeros((bsz, h, n, n), jnp.float32)
    _, ys = lax.scan(step, S0, seqs)
    return jnp.moveaxis(ys, 0, 1)


def causal_dwconv(u, w):
    seq = u.shape[1]
    up = jnp.pad(u, ((0, 0), (CONV_K - 1, 0), (0, 0)))
    y = w[0] * up[:, 0:seq]
    for j in range(1, CONV_K):
        y = y + w[j] * up[:, j:j + seq]
    return y


def mem_cross_attn(h, mem, gq, gkv, wq, wkv, wo):
    bsz, seq, _ = h.shape
    hn = rms_norm(h, gq)
    mn = rms_norm(mem, gkv)
    q = (hn @ wq).reshape(bsz, seq, MEM_HEADS, MEM_HEAD_DIM)
    k, v = jnp.split(mn @ wkv, 2, axis=-1)
    k = k.reshape(bsz, -1, MEM_HEADS, MEM_HEAD_DIM)
    v = v.reshape(bsz, -1, MEM_HEADS, MEM_HEAD_DIM)
    s = jnp.einsum('bqhd,bmhd->bhqm', q, k).astype(jnp.float32) * (MEM_HEAD_DIM ** -0.5)
    p = jax.nn.softmax(s, axis=-1).astype(v.dtype)
    o = jnp.einsum('bhqm,bmhd->bqhd', p, v).reshape(bsz, seq, MEM_HEADS * MEM_HEAD_DIM)
    return o @ wo


def hier_moe(h, rg, rgb, re, reb, wg, wu, wd):
    bsz, seq, d = h.shape
    n = h.reshape(bsz * seq, d)
    gp = jax.nn.softmax((n @ rg + rgb).astype(jnp.float32), axis=-1)
    g_w, g_i = lax.top_k(gp, 1)
    el = (n @ re + reb).astype(jnp.float32).reshape(-1, N_GROUPS, EXPERTS_PER_GROUP)
    el_sel = jnp.sum(el * jax.nn.one_hot(g_i[:, 0], N_GROUPS, dtype=jnp.float32)[:, :, None], axis=1)
    ep = jax.nn.softmax(el_sel, axis=-1)
    e_p, e_i = lax.top_k(ep, TOP_K_IN_GROUP)
    e_p = e_p / jnp.sum(e_p, axis=-1, keepdims=True)
    comb_w = g_w * e_p
    e_glob = g_i * EXPERTS_PER_GROUP + e_i
    combine = jnp.einsum('nk,nke->ne', comb_w,
                         jax.nn.one_hot(e_glob, N_EXPERTS, dtype=jnp.float32)).astype(n.dtype)
    out = jnp.zeros_like(n)
    for e in range(N_EXPERTS):
        he = jax.nn.silu(n @ wg[e]) * (n @ wu[e])
        out = out + combine[:, e:e + 1] * (he @ wd[e])
    return out.reshape(bsz, seq, d)


def setup_inputs(seed: int = 0) -> dict:
    key = jax.random.key(seed)
    ks = iter(jax.random.split(key, 64))
    L, D = DEPTH, D_MODEL

    def nrm(shape, scale):
        return jax.random.normal(next(ks), shape, jnp.float32) * scale

    def uni(shape, lo, hi):
        return jax.random.uniform(next(ks), shape, jnp.float32, lo, hi)

    def gain(shape):
        return 1.0 + nrm(shape, 0.02)

    return {
        "x": nrm((BATCH, SEQ, D), 1.0),
        "mem": nrm((BATCH, MEM_LEN, D), 1.0),
        "norm_mix": gain((L, D)),
        "w_in": nrm((L, D, IN_COLS), D ** -0.5),
        "mu_in": uni((L, RW_COLS), 0.0, 1.0),
        "w_vres_in": nrm((L - 1, D, LORA_VRES), D ** -0.5),
        "mu_vres": uni((L - 1, LORA_VRES), 0.0, 1.0),
        "w0": uni((L, RW_WIDTH), -6.0, -1.0),
        "w_decay_up": nrm((L, LORA_DECAY, RW_WIDTH), 0.1 * LORA_DECAY ** -0.5),
        "a0": nrm((L, RW_WIDTH), 0.5),
        "w_aaa_up": nrm((L, LORA_AAA, RW_WIDTH), LORA_AAA ** -0.5),
        "w_gate_up": nrm((L, LORA_GATE, RW_WIDTH), LORA_GATE ** -0.5),
        "v0": nrm((L - 1, RW_WIDTH), 0.5),
        "w_vres_up": nrm((L - 1, LORA_VRES, RW_WIDTH), LORA_VRES ** -0.5),
        "k_k": 0.85 + nrm((L, RW_WIDTH), 0.05),
        "k_a": 1.0 + nrm((L, RW_WIDTH), 0.05),
        "r_k": nrm((L, RW_HEADS, RW_HEAD_DIM), 0.1),
        "lnx_g": gain((L, RW_WIDTH)),
        "lnx_b": nrm((L, RW_WIDTH), 0.02),
        "conv_w": nrm((L, CONV_K, CONV_WIDTH), CONV_K ** -0.5),
        "gate_b": nrm((L, GATE_COLS), 0.1),
        "w_br_a": nrm((L, RW_WIDTH, D), RW_WIDTH ** -0.5),
        "w_br_b": nrm((L, CONV_WIDTH, D), CONV_WIDTH ** -0.5),
        "w_mix_out": nrm((L, D, D), D ** -0.5),
        "norm_memq": gain((L, D)),
        "norm_memkv": gain((L, D)),
        "wq_mem": nrm((L, D, MEM_HEADS * MEM_HEAD_DIM), D ** -0.5),
        "wkv_mem": nrm((L, D, 2 * MEM_HEADS * MEM_HEAD_DIM), D ** -0.5),
        "wo_mem": nrm((L, MEM_HEADS * MEM_HEAD_DIM, D), (MEM_HEADS * MEM_HEAD_DIM) ** -0.5),
        "norm_ffn": gain((L, D)),
        "router_g": nrm((L, D, N_GROUPS), D ** -0.5),
        "router_g_b": nrm((L, N_GROUPS), 0.01),
        "router_e": nrm((L, D, N_EXPERTS), D ** -0.5),
        "router_e_b": nrm((L, N_EXPERTS), 0.01),
        "w_e_gate": nrm((L, N_EXPERTS, D, D_EXPERT), D ** -0.5),
        "w_e_up": nrm((L, N_EXPERTS, D, D_EXPERT), D ** -0.5),
        "w_e_down": nrm((L, N_EXPERTS, D_EXPERT, D), D_EXPERT ** -0.5),
        "norm_f": gain((D,)),
    }


def reference(x, mem, norm_mix, w_in, mu_in, w_vres_in, mu_vres, w0, w_decay_up, a0,
              w_aaa_up, w_gate_up, v0, w_vres_up, k_k, k_a, r_k, lnx_g, lnx_b, conv_w,
              gate_b, w_br_a, w_br_b, w_mix_out, norm_memq, norm_memkv, wq_mem, wkv_mem,
              wo_mem, norm_ffn, router_g, router_g_b, router_e, router_e_b, w_e_gate,
              w_e_up, w_e_down, norm_f):
    bsz, seq, _ = x.shape
    f32 = jnp.float32

    def heads(z):
        return z.reshape(bsz, seq, RW_HEADS, RW_HEAD_DIM).astype(f32)

    v_first = None
    for l in range(DEPTH):
        xn = rms_norm(x, norm_mix[l])
        w_proj = w_in[l] if l == 0 else jnp.concatenate([w_in[l], w_vres_in[l - 1]], axis=1)
        p = xn @ w_proj
        rw = shift_mix(p[..., :RW_COLS], mu_in[l])
        conv_cols = p[..., RW_COLS:RW_COLS + CONV_COLS]
        gate_cols = p[..., RW_COLS + CONV_COLS:IN_COLS]

        o = 0
        r = rw[..., o:o + RW_WIDTH]; o += RW_WIDTH
        k = rw[..., o:o + RW_WIDTH]; o += RW_WIDTH
        v = rw[..., o:o + RW_WIDTH]; o += RW_WIDTH
        wd = rw[..., o:o + LORA_DECAY]; o += LORA_DECAY
        ad = rw[..., o:o + LORA_AAA]; o += LORA_AAA
        gd = rw[..., o:o + LORA_GATE]

        wlog = -jax.nn.softplus(-(w0[l] + jnp.tanh(wd) @ w_decay_up[l]).astype(f32)) - 0.5
        decay = jnp.exp(-jnp.exp(wlog))
        aa = jax.nn.sigmoid(a0[l] + ad @ w_aaa_up[l])
        og = jax.nn.sigmoid(gd) @ w_gate_up[l]
        if l == 0:
            v_first = v
        else:
            vd = shift_mix(p[..., IN_COLS:], mu_vres[l - 1])
            v = v + (v_first - v) * jax.nn.sigmoid(v0[l - 1] + vd @ w_vres_up[l - 1])
        kk = heads(k * k_k[l])
        kk = kk / jnp.maximum(jnp.sqrt(jnp.sum(kk * kk, axis=-1, keepdims=True)), L2_EPS)
        k = k * (1.0 + (aa - 1.0) * k_a[l])
        rh, kh, vh = heads(r), heads(k), heads(v)
        y = wkv7_scan(rh, heads(decay), kh, vh, -kk, kk * heads(aa))
        y_mu = jnp.mean(y, axis=-1, keepdims=True)
        y_var = jnp.mean(jnp.square(y - y_mu), axis=-1, keepdims=True)
        y = ((y - y_mu) * lax.rsqrt(y_var + LNX_EPS)).reshape(bsz, seq, RW_WIDTH)
        y = y * lnx_g[l] + lnx_b[l]
        bonus = jnp.sum(rh * kh * r_k[l], axis=-1, keepdims=True) * vh
        y_a = ((y + bonus.reshape(bsz, seq, RW_WIDTH)) * og).astype(x.dtype)

        cx = conv_cols[..., :CONV_WIDTH]
        cb = conv_cols[..., CONV_WIDTH:2 * CONV_WIDTH]
        cc = conv_cols[..., 2 * CONV_WIDTH:]
        y_b = cb * causal_dwconv(cc * cx, conv_w[l])

        gts = gate_cols + gate_b[l]
        g_a = jax.nn.sigmoid(gts[..., :D_MODEL])
        g_b = jax.nn.sigmoid(gts[..., D_MODEL:])
        merged = g_a * (y_a @ w_br_a[l]) + g_b * (y_b @ w_br_b[l])
        x = x + merged @ w_mix_out[l]

        x = x + mem_cross_attn(x, mem, norm_memq[l], norm_memkv[l], wq_mem[l], wkv_mem[l], wo_mem[l])

        hn = rms_norm(x, norm_ffn[l])
        x = x + hier_moe(hn, router_g[l], router_g_b[l], router_e[l], router_e_b[l],
                         w_e_gate[l], w_e_up[l], w_e_down[l])

    return rms_norm(x, norm_f)
```

```cpp
#include <hip/hip_runtime.h>
#include <cstdio>
#include <cstdint>

#ifndef MK_ONE_LAUNCH
#define MK_ONE_LAUNCH 1
#endif

#define LAS __attribute__((address_space(3)))
#define GAS __attribute__((address_space(1)))
typedef unsigned short bf16_t;
typedef short bf16x8 __attribute__((ext_vector_type(8)));
typedef float f32x4 __attribute__((ext_vector_type(4)));
typedef float f32x2 __attribute__((ext_vector_type(2)));
typedef unsigned u32x4 __attribute__((ext_vector_type(4)));
typedef unsigned u32x2 __attribute__((ext_vector_type(2)));

constexpr int NT = 16384, DM = 1024, TT = 2048, NBATCH = 8, NHEAD = 16;
constexpr int LD1 = 3584;
constexpr int INC = 8480;
constexpr int NPH_L = 20, NPH = 1 + 2 * NPH_L;
constexpr float RMS_EPS = 1e-6f, LNX_EPS = 64e-5f;

constexpr size_t MiB = 1u << 20;
constexpr size_t WS_CTL = 0, CTL_ZERO_BYTES = 1 * MiB;
constexpr size_t WS_SMALL = 1 * MiB;
constexpr size_t WS_WGT = 3 * MiB;
constexpr size_t WS_SSBP = 36 * MiB;
constexpr size_t WS_KVB = 38 * MiB;
constexpr size_t WS_XB = 54 * MiB;
constexpr size_t WS_VF = 86 * MiB;
constexpr size_t WS_P1 = 118 * MiB;
constexpr size_t WS_HALO = 230 * MiB;
constexpr size_t WS_STR = 231 * MiB;
constexpr size_t WS_END = 359 * MiB;
constexpr size_t WG_W1A = 0, WG_W1B = 7 * MiB, WG_WX1 = 17 * MiB, WG_WX2 = WG_WX1 + 3 * MiB / 2, WG_WBA = 19 * MiB, WG_WBB = 21 * MiB, WG_WMO = 23 * MiB, WG_WQ = 25 * MiB, WG_WO = 27 * MiB;
constexpr size_t ST_KK = 0, ST_WE = 32 * MiB, ST_AA = 64 * MiB, ST_OG = 96 * MiB;
constexpr size_t ST_U = 0, ST_CB = 32 * MiB, ST_GA = 64 * MiB, ST_GB = 96 * MiB;
constexpr size_t ST_PS = 0, ST_PB = 64 * MiB;
constexpr size_t ST_MN = 0, ST_WKVT = 8 * MiB;
constexpr size_t WS_XP = 118 * MiB, WS_H = 190 * MiB, WS_WE1 = 226 * MiB, WS_WE2 = 258 * MiB;
constexpr int XP_ROWS = 36864;
constexpr size_t SM_SSA = 0, SM_SF = 64 * 1024, SM_TOKE = 128 * 1024, SM_TOKW = 256 * 1024, SM_TOKPOS = 384 * 1024, SM_ROWS = 512 * 1024, SM_ROWW = 672 * 1024,
                 SM_RINV = 832 * 1024, SM_BC = 1088 * 1024, SM_MOEINFO = 1104 * 1024, SM_ROWTOK = 1120 * 1024;
constexpr int CW_BAR = 4096;
constexpr size_t CT_SSB = 64 * 1024;

constexpr int RING_BYTES = 131072, LDS_BYTES = 147456, LDSCTL_OFF = LDS_BYTES - 512, MISC_OFF = LDSCTL_OFF + 320;

typedef __bf16 bf16v2_t __attribute__((ext_vector_type(2)));
__device__ __forceinline__ unsigned cvt_pk_bf16(float lo, float hi) { const f32x2 v = {lo, hi}; const bf16v2_t r = __builtin_convertvector(v, bf16v2_t); return __builtin_bit_cast(unsigned, r); }
__device__ __forceinline__ float bflo(unsigned w) { return __uint_as_float(w << 16); }
__device__ __forceinline__ float bfhi(unsigned w) { return __uint_as_float(w & 0xffff0000u); }
__device__ __forceinline__ float sigm(float x) { return 1.0f / (1.0f + __expf(-x)); }
__device__ __forceinline__ void unpack8(const u32x4 w, float (&f)[8]) { f[0] = bflo(w.x); f[1] = bfhi(w.x); f[2] = bflo(w.y); f[3] = bfhi(w.y); f[4] = bflo(w.z); f[5] = bfhi(w.z); f[6] = bflo(w.w); f[7] = bfhi(w.w); }
__device__ __forceinline__ u32x4 pack8(const float (&f)[8]) { u32x4 w; w.x = cvt_pk_bf16(f[0], f[1]); w.y = cvt_pk_bf16(f[2], f[3]); w.z = cvt_pk_bf16(f[4], f[5]); w.w = cvt_pk_bf16(f[6], f[7]); return w; }
template <int CTRL> __device__ __forceinline__ float dppf(float x) { return __int_as_float(__builtin_amdgcn_update_dpp(0, __float_as_int(x), CTRL, 0xf, 0xf, false)); }
__device__ __forceinline__ float sum8(float x) { x += dppf<0xB1>(x); x += dppf<0x4E>(x); x += dppf<0x141>(x); return x; }
__device__ __forceinline__ float sum16(float x) { x = sum8(x); x += dppf<0x140>(x); return x; }
__device__ __forceinline__ float wave_sum(float v) {
    v = sum16(v);
    v += __int_as_float(__builtin_amdgcn_update_dpp(0, __float_as_int(v), 0x142, 0xa, 0xf, false));
    v += __int_as_float(__builtin_amdgcn_update_dpp(0, __float_as_int(v), 0x143, 0xc, 0xf, false));
    return __int_as_float(__builtin_amdgcn_readlane(__float_as_int(v), 63));
}
__device__ __forceinline__ float wave_max(float v) {
    v = fmaxf(v, dppf<0xB1>(v)); v = fmaxf(v, dppf<0x4E>(v)); v = fmaxf(v, dppf<0x141>(v)); v = fmaxf(v, dppf<0x140>(v));
    const float b = __int_as_float(__builtin_amdgcn_readlane(__float_as_int(v), 16)), c = __int_as_float(__builtin_amdgcn_readlane(__float_as_int(v), 32));
    return fmaxf(fmaxf(__int_as_float(__builtin_amdgcn_readlane(__float_as_int(v), 0)), b), fmaxf(c, __int_as_float(__builtin_amdgcn_readlane(__float_as_int(v), 48))));
}
__device__ __forceinline__ int fresh_lane() { int l; asm volatile("v_mbcnt_lo_u32_b32 %0, -1, 0\n\tv_mbcnt_hi_u32_b32 %0, -1, %0" : "=v"(l)); return l; }
__device__ __forceinline__ void memclob() { asm volatile("" ::: "memory"); }
#define LDS_WAIT() asm volatile("s_waitcnt lgkmcnt(0)" ::: "memory")
#define VM_WAIT() asm volatile("s_waitcnt vmcnt(0)" ::: "memory")

struct Args { const float* in[38]; float* out; unsigned char* ws; int ph_lo, ph_hi; };
struct Ctx {
    const float* in[38];
    float* out;
    unsigned char* ws;
    int G, bid, tid, lane, wave;
};
#define CIN(i) (C.in[(i)])
#define WSP(T, off) ((T*)(C.ws + (off)))

namespace pg8 {
constexpr int BM = 256, BK = 64, HALF = 128, HTB = HALF * BK * 2, STAGE_BYTES = 8 * HTB;
__host__ __device__ __forceinline__ int lds_byte(int r, int c) { const int st = (r >> 4) * 2 + (c >> 5), rr = r & 15, cc = c & 31, ob = rr * 64 + cc * 2; return st * 1024 + (ob ^ (((ob >> 9) & 1) << 5)); }
__host__ __device__ __forceinline__ void stage_rc(int b, int& R, int& Cc) { const int st = b / 1024, sb = b % 1024, swz = sb ^ (((sb >> 9) & 1) << 5); R = (st >> 1) * 16 + swz / 64; Cc = (st & 1) * 32 + (swz % 64) / 2; }
__host__ __device__ __forceinline__ int perm32(int rho) { const int n = rho >> 4, i = rho & 15; return 8 * (i >> 2) + 4 * n + (i & 3); }
struct Unit { int pm, pn, seg, pad; const char* a; const char* b; };

template <int K, int lda, int ldb, class Epi, class Sched, bool GATHER = false>
__device__ __forceinline__ void gemm_phase(LAS unsigned char* lds, const int tid, const Sched& S, const Epi& E, const int* rowtok = nullptr) {
    const int wid = __builtin_amdgcn_readfirstlane(tid >> 6), lane = tid & 63, wr = wid >> 2, wc = wid & 3, fr = lane & 15, fq = lane >> 4;
    constexpr int nt = K / BK;
    unsigned voffA[2], voffB[2];
#pragma unroll
    for (int i = 0; i < 2; ++i) { int R, Cc; stage_rc(tid * 16 + i * 8192, R, Cc); const int Rb = (R & ~31) + perm32(R & 31);
        voffA[i] = (unsigned)(R * lda + Cc) * 2u; voffB[i] = (unsigned)(Rb * ldb + Cc) * 2u; }
    const size_t kstep = (size_t)(BK * 2);
    const size_t hstepA = (size_t)HALF * lda * 2, hstepB = (size_t)HALF * ldb * 2;
    const unsigned ldsw = (unsigned)wid * 1024u;
    const int aoff = lds_byte(wr * 64 + fr, fq * 8), boff = lds_byte(wc * 32 + fr, fq * 8);
#define PG8_SA(b, h) (((b) * 2 + (h)) * HTB)
#define PG8_SB(b, h) ((4 + (b) * 2 + (h)) * HTB)
#define PG8_STAGE(bufoff, gbase, voff) do { _Pragma("unroll") for (int _i = 0; _i < 2; ++_i) \
        __builtin_amdgcn_global_load_lds((const unsigned*)((const char*)(gbase) + (voff)[_i]), (LAS unsigned*)(lds + (bufoff) + ldsw + _i * 8192), 16, 0, 0); } while (0)
#define PG8_LDA(dst, b, h) do { _Pragma("unroll") for (int m = 0; m < 4; ++m) _Pragma("unroll") for (int k = 0; k < 2; ++k) dst[m][k] = *(const LAS bf16x8*)(lds + PG8_SA(b, h) + aoff + m * 2048 + k * 1024); } while (0)
#define PG8_LDB(dst, b, h) do { _Pragma("unroll") for (int n = 0; n < 2; ++n) _Pragma("unroll") for (int k = 0; k < 2; ++k) dst[n][k] = *(const LAS bf16x8*)(lds + PG8_SB(b, h) + boff + n * 2048 + k * 1024); } while (0)
#define PG8_MMA(ai, bj, At, Bt) do { __builtin_amdgcn_s_setprio(1); _Pragma("unroll") for (int m = 0; m < 4; ++m) _Pragma("unroll") for (int n = 0; n < 2; ++n) _Pragma("unroll") for (int k = 0; k < 2; ++k) \
        acc[ai][bj][m][n] = __builtin_amdgcn_mfma_f32_16x16x32_bf16(Bt[n][k], At[m][k], acc[ai][bj][m][n], 0, 0, 0); __builtin_amdgcn_s_setprio(0); } while (0)
#define PG8_WAIT_V(n) asm volatile("s_waitcnt vmcnt(" #n ")" ::: "memory")
#define PG8_WAIT_L(n) asm volatile("s_waitcnt lgkmcnt(" #n ")" ::: "memory")
#define PG8_BAR __builtin_amdgcn_s_barrier()
#define PG8_SCHED __builtin_amdgcn_sched_barrier(0)
    Unit cur, nxt; int ui = 0;
    if (!S.next(0, cur)) return;
    f32x4 acc[2][2][4][2];
    bf16x8 At[4][2], B0[2][2], B1[2][2];
    const char* cA = cur.a; const char* cB = cur.b;
    unsigned gA[2][2], gN[2][2], gNN[2][2];
    if constexpr (GATHER) {
#pragma unroll
        for (int h = 0; h < 2; ++h)
#pragma unroll
            for (int i = 0; i < 2; ++i) { int R, Cc; stage_rc(tid * 16 + i * 8192, R, Cc);
                Unit t1, t2; const bool h1 = S.next(1, t1), h2 = S.next(2, t2);
                const int r0 = rowtok[cur.pm * 256 + h * 128 + R], r1 = h1 ? rowtok[t1.pm * 256 + h * 128 + R] : r0, r2 = h2 ? rowtok[t2.pm * 256 + h * 128 + R] : r1;
                gA[h][i] = (unsigned)(r0 * lda + Cc) * 2u; gN[h][i] = (unsigned)(r1 * lda + Cc) * 2u; gNN[h][i] = (unsigned)(r2 * lda + Cc) * 2u; }
    }
#define PG8_STAGE_A(bufoff, gbase, half, nx) do { if constexpr (GATHER) { _Pragma("unroll") for (int _i = 0; _i < 2; ++_i) { const unsigned vo_ = (nx) ? gN[half][_i] : gA[half][_i]; \
            __builtin_amdgcn_global_load_lds((const unsigned*)((const char*)(gbase) + vo_), (LAS unsigned*)(lds + (bufoff) + ldsw + _i * 8192), 16, 0, 0); } } \
        else PG8_STAGE(bufoff, (gbase) + (half) * hstepA, voffA); } while (0)
    PG8_STAGE(PG8_SB(0, 0), cB, voffB); PG8_STAGE(PG8_SB(0, 1), cB + hstepB, voffB); PG8_STAGE_A(PG8_SA(0, 0), cA, 0, false); PG8_STAGE_A(PG8_SA(0, 1), cA, 1, false);
    if (wr == 1) PG8_BAR;
    PG8_WAIT_V(2); PG8_BAR;
    PG8_STAGE(PG8_SB(1, 0), cB + kstep, voffB); PG8_STAGE_A(PG8_SA(1, 0), cA + kstep, 0, false); PG8_STAGE(PG8_SB(1, 1), cB + hstepB + kstep, voffB);
    PG8_WAIT_V(6); PG8_BAR;
#pragma unroll
    for (int a = 0; a < 2; ++a)
#pragma unroll
        for (int b = 0; b < 2; ++b)
#pragma unroll
            for (int m = 0; m < 4; ++m)
#pragma unroll
                for (int n = 0; n < 2; ++n) acc[a][b][m][n] = (f32x4){0.f, 0.f, 0.f, 0.f};
    for (;;) {
        const bool has_next = S.next(ui + 1, nxt);
        const char* nA = has_next ? nxt.a : cA; const char* nB = has_next ? nxt.b : cB;
        for (int t = 0; t < nt; t += 2) {
            const bool last = (t == nt - 2);
            const char* a1 = cA + (size_t)(t + 1) * kstep;
            const char* a2 = last ? nA : cA + (size_t)(t + 2) * kstep; const char* b2 = last ? nB : cB + (size_t)(t + 2) * kstep;
            const char* a3 = a2 + kstep; const char* b3 = b2 + kstep;
            PG8_LDB(B0, 0, 0); PG8_LDB(B1, 0, 1); PG8_SCHED; PG8_LDA(At, 0, 0); PG8_STAGE_A(PG8_SA(1, 1), a1, 1, false);
            PG8_WAIT_V(8); PG8_WAIT_L(0); PG8_BAR; PG8_MMA(0, 0, At, B0); PG8_MMA(0, 1, At, B1); PG8_BAR; PG8_SCHED;
            PG8_LDA(At, 0, 1); PG8_STAGE(PG8_SB(0, 0), b2, voffB); PG8_STAGE(PG8_SB(0, 1), b2 + hstepB, voffB); PG8_STAGE_A(PG8_SA(0, 0), a2, 0, last && has_next);
            PG8_WAIT_V(8); PG8_WAIT_L(0); PG8_BAR; PG8_MMA(1, 0, At, B0); PG8_MMA(1, 1, At, B1); PG8_BAR; PG8_SCHED;
            PG8_LDB(B0, 1, 0); PG8_LDB(B1, 1, 1); PG8_SCHED; PG8_LDA(At, 1, 0); PG8_STAGE_A(PG8_SA(0, 1), a2, 1, last && has_next);
            PG8_WAIT_V(8); PG8_WAIT_L(0); PG8_BAR; PG8_MMA(0, 0, At, B0); PG8_MMA(0, 1, At, B1); PG8_BAR; PG8_SCHED;
            PG8_LDA(At, 1, 1); PG8_STAGE(PG8_SB(1, 0), b3, voffB); PG8_STAGE(PG8_SB(1, 1), b3 + hstepB, voffB); PG8_STAGE_A(PG8_SA(1, 0), a3, 0, last && has_next);
            PG8_WAIT_V(8); PG8_WAIT_L(0); PG8_BAR; PG8_MMA(1, 0, At, B0); PG8_MMA(1, 1, At, B1); PG8_BAR; PG8_SCHED;
        }
        if (wr == 0) PG8_BAR;
        E(acc, cur, wr, wc, fr, fq);
        if (!has_next) break;
#pragma unroll
        for (int a = 0; a < 2; ++a)
#pragma unroll
            for (int b = 0; b < 2; ++b)
#pragma unroll
                for (int m = 0; m < 4; ++m)
#pragma unroll
                    for (int n = 0; n < 2; ++n) acc[a][b][m][n] = (f32x4){0.f, 0.f, 0.f, 0.f};
        cur = nxt; cA = nA; cB = nB; ++ui;
        if constexpr (GATHER) {
#pragma unroll
            for (int h = 0; h < 2; ++h)
#pragma unroll
                for (int i = 0; i < 2; ++i) { gA[h][i] = gN[h][i]; gN[h][i] = gNN[h][i]; } }
        if (wr == 1) PG8_BAR;
    }
    PG8_WAIT_V(0);
    PG8_BAR;
#undef PG8_SA
#undef PG8_SB
#undef PG8_STAGE
#undef PG8_STAGE_A
#undef PG8_LDA
#undef PG8_LDB
#undef PG8_MMA
#undef PG8_WAIT_V
#undef PG8_WAIT_L
#undef PG8_BAR
#undef PG8_SCHED
}
}

#define XB_TMO      128
#define XB_XCNT(j)  (256  + 64 * (j))
#define XB_XSUB(j)  (1280 + 64 * (j))
#define XB_XGEN(j)  (2304 + 64 * (j))
#define XB_TOP      3328
#define XB_TOPGEN   3392
#define XCD_BAR_WORDS 3456
#define XB_SPIN_CAP (1u << 18)
__device__ __forceinline__ unsigned xb_ld(unsigned* p)              { return __hip_atomic_load(p, __ATOMIC_RELAXED, __HIP_MEMORY_SCOPE_AGENT); }
__device__ __forceinline__ unsigned xb_add(unsigned* p, unsigned v) { return __hip_atomic_fetch_add(p, v, __ATOMIC_RELAXED, __HIP_MEMORY_SCOPE_AGENT); }
__device__ __forceinline__ unsigned xb_xcc_id() { return (unsigned)__builtin_amdgcn_s_getreg((3 << 11) | 20) & 0xFu; }
#define XB_SPIN(cond, bar) do { unsigned _sp = 0; while (cond) { __builtin_amdgcn_s_sleep(1); \
    if ((++_sp & 255u) == 0u) { if (xb_ld(&(bar)[XB_TMO])) break; if (_sp > XB_SPIN_CAP) { atomicAdd(&(bar)[XB_TMO], 1u); break; } } } } while (0)
struct XcdBarrier { unsigned* bar; unsigned x; volatile LAS unsigned* st; };
__device__ __forceinline__ XcdBarrier xcd_barrier_post(unsigned* bar, volatile LAS unsigned* st) {
    XcdBarrier b; b.bar = bar; b.x = xb_xcc_id(); b.st = st;
    if (threadIdx.x == 0) (void)xb_add(&bar[XB_XCNT(b.x)], 1u);
    return b;
}
__device__ __forceinline__ void xcd_barrier_complete(unsigned* bar, unsigned x, unsigned& nloc, unsigned& nx) {
    const unsigned G = gridDim.x * gridDim.y * gridDim.z;
    unsigned sum, cnt, mine, sp = 0u;
    for (;;) {
        sum = 0u; cnt = 0u; mine = 0u;
#pragma unroll
        for (unsigned j = 0; j < 16; ++j) { const unsigned c = xb_ld(&bar[XB_XCNT(j)]); sum += c; cnt += (c > 0u) ? 1u : 0u; mine = (j == x) ? c : mine; }
        if (sum == G) break;
        __builtin_amdgcn_s_sleep(1);
        if ((++sp & 255u) == 0u) { if (xb_ld(&bar[XB_TMO])) break; if (sp > XB_SPIN_CAP) { atomicAdd(&bar[XB_TMO], 1u); break; } }
    }
    nloc = mine > 0u ? mine : 1u; nx = cnt > 0u ? cnt : 1u;
}
__device__ __forceinline__ void xcd_barrier(const XcdBarrier& b) {
    asm volatile("s_waitcnt vmcnt(0)" ::: "memory");
    __syncthreads();
    if (threadIdx.x == 0) {
        unsigned* bar = b.bar;
        __builtin_amdgcn_s_waitcnt(0);
        unsigned nloc = b.st[0], nx = b.st[1];
        if (nloc == 0u) { xcd_barrier_complete(bar, b.x, nloc, nx); b.st[0] = nloc; b.st[1] = nx; }
        const unsigned old = xb_add(&bar[XB_XSUB(b.x)], 1u);
        const unsigned gen = old / nloc;
        if (old + 1u == (gen + 1u) * nloc) {
            __builtin_amdgcn_fence(__ATOMIC_RELEASE, "agent");
            asm volatile("s_waitcnt vmcnt(0)" ::: "memory");
            const unsigned og = xb_add(&bar[XB_TOP], 1u);
            const unsigned tg = og / nx;
            if (og + 1u == (tg + 1u) * nx) xb_add(&bar[XB_TOPGEN], 1u);
            else XB_SPIN(xb_ld(&bar[XB_TOPGEN]) == tg, bar);
            __builtin_amdgcn_fence(__ATOMIC_ACQUIRE, "agent");
            xb_add(&bar[XB_XGEN(b.x)], 1u);
            asm volatile("s_waitcnt vmcnt(0)" ::: "memory");
        } else {
            XB_SPIN(xb_ld(&bar[XB_XGEN(b.x)]) == gen, bar);
            __builtin_amdgcn_fence(__ATOMIC_ACQUIRE, "agent");
            asm volatile("s_waitcnt vmcnt(0)" ::: "memory");
        }
    }
    __syncthreads();
}

enum GemmKind { GK_S11 = 0, GK_X, GK_S15, GK_DENSE, GK_ATTS, GK_ATTO, GK_MOE1, GK_MOE2, GK_ATTQ };
enum EpiMode { EM_P1 = 0, EM_X, EM_S15, EM_M1, EM_MG, EM_RES, EM_Q, EM_ATTS, EM_ATTO, EM_MOE1, EM_MOE2 };

__device__ __forceinline__ void dense_unit(int L, int nM, int nN, int& pm, int& pn) {
    const int nwg = nM * nN; int wgid = L;
    { const int q = nwg / 8, r = nwg % 8, xcd = wgid % 8, off = wgid / 8; wgid = (xcd < r ? xcd * (q + 1) : r * (q + 1) + (xcd - r) * q) + off; }
    const int nig = 8 * nN, gid = wgid / nig, fm = gid * 8, gsz = (nM - fm) < 8 ? (nM - fm) : 8;
    pm = fm + ((wgid % nig) % gsz); pn = (wgid % nig) / gsz;
}

template <int kind> struct Sched {
    int G, c, layer;
    const char* A; const char* B;
    int nM, nN, lda, ldb;
    const unsigned char* ws;
    __device__ __forceinline__ bool next(int i, pg8::Unit& u) const {
        const int L = i * G + c;
        u.seg = 0; u.pad = 0;
        if constexpr (kind == GK_S11) {
            const int n0 = 64 * 14;
            if (L < n0) { dense_unit(L, 64, 14, u.pm, u.pn); u.a = (const char*)(ws + WS_XB) + (size_t)u.pm * 256 * 2048; u.b = (const char*)(ws + WS_WGT + WG_W1A) + (size_t)u.pn * 256 * 2048; return true; }
            if (layer != 0) return false;
            const int r = L - n0; if (r >= 128) return false;
            const int sg = r >> 5, idx = r & 31, l2 = sg >> 1;
            const char* mn = (const char*)(ws + WS_STR + ST_MN) + (size_t)l2 * 4 * MiB;
            const char* wk = (const char*)(ws + WS_STR + ST_WKVT) + (size_t)l2 * 4 * MiB;
            u.seg = 1 + sg;
            if ((sg & 1) == 0) { u.pm = idx >> 2; u.pn = idx & 3; u.a = mn + (size_t)u.pm * 256 * 2048; u.b = wk + (size_t)u.pn * 256 * 2048; }
            else { u.pm = idx >> 3; u.pn = idx & 7; u.a = wk + (size_t)(1024 + u.pm * 256) * 2048; u.b = mn + (size_t)u.pn * 256 * 2048; }
            return true; }
        else if constexpr (kind == GK_X) {
            const int nN1 = layer ? 12 : 8, n0 = 64 * nN1;
            const char* p1 = (const char*)(ws + WS_P1);
            if (L < n0) { dense_unit(L, 64, nN1, u.pm, u.pn); u.a = p1 + (size_t)u.pm * 256 * LD1 * 2 + 3072 * 2; u.b = (const char*)(ws + WS_WGT + WG_WX1) + (size_t)u.pn * 256 * 512; return true; }
            const int r = L - n0; if (r >= 256) return false;
            u.seg = 1; dense_unit(r, 64, 4, u.pm, u.pn); u.a = p1 + (size_t)u.pm * 256 * LD1 * 2 + 3328 * 2; u.b = (const char*)(ws + WS_WGT + WG_WX2) + (size_t)u.pn * 256 * 512; return true; }
        else if constexpr (kind == GK_S15) {
            if (L >= 64 * 20) return false;
            dense_unit(L, 64, 20, u.pm, u.pn); u.a = (const char*)(ws + WS_XB) + (size_t)u.pm * 256 * 2048; u.b = (const char*)(ws + WS_WGT + WG_W1B) + (size_t)u.pn * 256 * 2048; return true; }
        else if constexpr (kind == GK_DENSE) {
            if (L >= nM * nN) return false;
            dense_unit(L, nM, nN, u.pm, u.pn); u.a = A + (size_t)u.pm * 256 * lda * 2; u.b = B + (size_t)u.pn * 256 * ldb * 2; return true; }
        else if constexpr (kind == GK_ATTQ) {
            if (L >= 256) return false;
            const int b = L >> 5, h = (L >> 3) & 3, qp = L & 7;
            u.pm = b * 8 + qp; u.pn = h;
            u.a = A + (size_t)u.pm * 256 * lda * 2; u.b = B + (size_t)u.pn * 256 * ldb * 2; return true; }
        else if constexpr (kind == GK_ATTS || kind == GK_ATTO) {
            if (L >= 256) return false;
            const int b = L >> 5, h = (L >> 3) & 3, qp = L & 7;
            u.pm = b * 8 + qp; u.pn = h;
            const char* kvb = (const char*)(ws + WS_KVB) + (size_t)layer * 8 * MiB;
            if (kind == GK_ATTS) { u.a = (const char*)(ws + WS_P1) + ((size_t)u.pm * 256 * 1024 + h * 256) * 2; u.b = kvb + ((size_t)b * 256 * 1024 + h * 256) * 2; }
            else { u.a = (const char*)(ws + WS_STR + ST_PB) + ((size_t)u.pm * 256 * 1024 + h * 256) * 2; u.b = kvb + 4 * MiB + ((size_t)h * 256 * 2048 + b * 256) * 2; }
            return true; }
        else {
            const int* info = (const int*)(ws + WS_SMALL + SM_MOEINFO);
            if (L >= info[32 + 16]) return false;
            int e = 0;
#pragma unroll 1
            for (int j = 1; j < 16; ++j) if (L >= info[32 + j]) e = j;
            const int loc = L - info[32 + e];
            u.pm = info[e] + (loc >> 2); u.pn = loc & 3; u.seg = e;
            if (kind == GK_MOE1) { u.a = (const char*)(ws + WS_XB); u.b = (const char*)(ws + WS_WE1) + ((size_t)e * 1024 + u.pn * 256) * 2048; }
            else { u.a = (const char*)(ws + WS_H) + (size_t)u.pm * 256 * 1024; u.b = (const char*)(ws + WS_WE2) + ((size_t)e * 1024 + u.pn * 256) * 1024; }
            return true; }
    }
};

template <int mode> struct Epi {
    int layer;
    const float* ep[4];
    float* out; unsigned char* ws;
    bool want_ss;
    LAS unsigned char* xlds;
    __device__ __forceinline__ void operator()(const f32x4 (&acc)[2][2][4][2], const pg8::Unit& u, int wr, int wc, int fr_, int fq_) const {
        const int ln_ = fresh_lane(), fr = ln_ & 15, fq = ln_ >> 4;
        const int rbase = u.pm * 256 + wr * 64 + fr;
        const int cl = wc * 32 + 8 * fq;
        const int l = layer;
#define ROWS_LOOP _Pragma("unroll") for (int ai = 0; ai < 2; ++ai) _Pragma("unroll") for (int m = 0; m < 4; (memclob(), ++m))
#define ROW_OF(ai, m) (rbase + (ai) * 128 + (m) * 16)
#define ACC8(bj) const f32x4 v0 = acc[ai][bj][m][0], v1 = acc[ai][bj][m][1]; float v[8] = {v0[0], v0[1], v0[2], v0[3], v1[0], v1[1], v1[2], v1[3]};
#define LOAD8F(dst, p) { const f32x4 t0_ = *(const GAS f32x4*)(p), t1_ = *(const GAS f32x4*)((p) + 4); dst[0] = t0_[0]; dst[1] = t0_[1]; dst[2] = t0_[2]; dst[3] = t0_[3]; dst[4] = t1_[0]; dst[5] = t1_[1]; dst[6] = t1_[2]; dst[7] = t1_[3]; }
        if constexpr (mode == EM_P1) {
            bf16_t* dst; int ld; bool sc = false, halo = false;
            if (u.seg == 0) { dst = (bf16_t*)(ws + WS_P1); ld = LD1; sc = true; halo = true; }
            else { const int sg = u.seg - 1, l2 = sg >> 1; bf16_t* kvb = (bf16_t*)(ws + WS_KVB + (size_t)l2 * 8 * MiB); if ((sg & 1) == 0) { dst = kvb; ld = 1024; } else { dst = kvb + 2 * 1024 * 1024; ld = 2048; } }
            const float* ssa = (const float*)(ws + WS_SMALL + SM_SSA);
            float sv[8];
#pragma unroll
            for (int r8 = 0; r8 < 8; ++r8) sv[r8] = sc ? *(const GAS float*)(ssa + ROW_OF(r8 >> 2, r8 & 3)) : 0.f;
#pragma unroll
            for (int r8 = 0; r8 < 8; ++r8) sv[r8] = sc ? rsqrtf(sv[r8] * (1.0f / 1024.0f) + RMS_EPS) : 1.0f;
            ROWS_LOOP { const int row = ROW_OF(ai, m); const float s = sv[ai * 4 + m];
#pragma unroll
                for (int bj = 0; bj < 2; ++bj) { ACC8(bj)
#pragma unroll
                    for (int j = 0; j < 8; ++j) v[j] *= s;
                    const int col = u.pn * 256 + bj * 128 + cl; const u32x4 w = pack8(v);
                    *(GAS u32x4*)(dst + (size_t)row * ld + col) = w;
                    if (halo && (row & 255) == 255) *(GAS u32x4*)((bf16_t*)(ws + WS_HALO) + (size_t)u.pm * LD1 + col) = w;
                    if (halo && (row & 63) == 63 && col < 2048) *(GAS u32x4*)((bf16_t*)(ws + 34 * MiB) + (size_t)(row >> 6) * 2048 + col) = w; } }
        }
        else if constexpr (mode == EM_X) {
            bf16_t* p1 = (bf16_t*)(ws + WS_P1);
            if (u.seg == 1) { bf16_t* og = (bf16_t*)(ws + WS_STR + ST_OG);
                ROWS_LOOP { const int row = ROW_OF(ai, m);
#pragma unroll
                    for (int bj = 0; bj < 2; ++bj) { ACC8(bj) *(GAS u32x4*)(og + (size_t)row * 1024 + u.pn * 256 + bj * 128 + cl) = pack8(v); } }
            } else {
                const int typ = u.pn >> 2, cb0 = (u.pn & 3) * 256;
                const float* bias = typ == 0 ? ep[0] + l * 1024 : (typ == 1 ? ep[1] + l * 1024 : ep[2]);
                const float* ka = ep[3] + l * 1024;
                bf16_t* we = (bf16_t*)(ws + WS_STR + ST_WE); bf16_t* aa = (bf16_t*)(ws + WS_STR + ST_AA); const bf16_t* vf = (const bf16_t*)(ws + WS_VF);
#pragma unroll
                for (int bj = 0; bj < 2; ++bj) { const int c0 = cb0 + bj * 128 + cl;
#pragma unroll
                    for (int ai = 0; ai < 2; ++ai)
#pragma unroll
                        for (int mh = 0; mh < 2; ++mh) {
                            float bb[8]; LOAD8F(bb, bias + c0)
                            if (typ == 0) {
#pragma unroll
                                for (int m2 = 0; m2 < 2; ++m2) { const int m = 2 * mh + m2; const int row = ROW_OF(ai, m); ACC8(bj)
#pragma unroll
                                    for (int j = 0; j < 8; ++j) v[j] = 0.60653065971f * sigm(v[j] + bb[j]);
                                    *(GAS u32x4*)(we + (size_t)row * 1024 + c0) = pack8(v); }
                            } else if (typ == 1) {
#pragma unroll
                                for (int m2 = 0; m2 < 2; ++m2) { const int m = 2 * mh + m2; const int row = ROW_OF(ai, m); ACC8(bj)
#pragma unroll
                                    for (int j = 0; j < 8; ++j) v[j] = sigm(v[j] + bb[j]);
                                    *(GAS u32x4*)(aa + (size_t)row * 1024 + c0) = pack8(v); }
                            } else {
                                u32x4 vr[2], fr4[2];
#pragma unroll
                                for (int m2 = 0; m2 < 2; ++m2) { vr[m2] = *(const GAS u32x4*)(p1 + (size_t)ROW_OF(ai, 2 * mh + m2) * LD1 + 2048 + c0); fr4[m2] = *(const GAS u32x4*)(vf + (size_t)ROW_OF(ai, 2 * mh + m2) * 1024 + c0); }
#pragma unroll
                                for (int m2 = 0; m2 < 2; ++m2) { const int m = 2 * mh + m2; const int row = ROW_OF(ai, m); ACC8(bj) float vv[8], vff[8]; unpack8(vr[m2], vv); unpack8(fr4[m2], vff);
#pragma unroll
                                    for (int j = 0; j < 8; ++j) vv[j] = vv[j] + (vff[j] - vv[j]) * sigm(v[j] + bb[j]);
                                    *(GAS u32x4*)(p1 + (size_t)row * LD1 + 2048 + c0) = pack8(vv); }
                            }
                            memclob();
                        }
                }
            }
        }
        else if constexpr (mode == EM_S15) {
            const float* ssa = (const float*)(ws + WS_SMALL + SM_SSA);
            float sv[8];
#pragma unroll
            for (int r8 = 0; r8 < 8; ++r8) sv[r8] = *(const GAS float*)(ssa + ROW_OF(r8 >> 2, r8 & 3));
#pragma unroll
            for (int r8 = 0; r8 < 8; ++r8) sv[r8] = rsqrtf(sv[r8] * (1.0f / 1024.0f) + RMS_EPS);
            if (u.pn < 8) { bf16_t* U = (bf16_t*)(ws + WS_STR + ST_U);
                ROWS_LOOP { const int row = ROW_OF(ai, m); const float s = sv[ai * 4 + m], s2 = s * s;
                    const f32x4 x0 = acc[ai][0][m][0], x1 = acc[ai][0][m][1], c0 = acc[ai][1][m][0], c1 = acc[ai][1][m][1];
                    float v[8] = {x0[0] * c0[0] * s2, x0[1] * c0[1] * s2, x0[2] * c0[2] * s2, x0[3] * c0[3] * s2, x1[0] * c1[0] * s2, x1[1] * c1[1] * s2, x1[2] * c1[2] * s2, x1[3] * c1[3] * s2};
                    *(GAS u32x4*)(U + (size_t)row * 1024 + u.pn * 128 + cl) = pack8(v); }
            } else {
                const int typ = (u.pn - 8) >> 2, cb0 = ((u.pn - 8) & 3) * 256;
                bf16_t* dst = (bf16_t*)(ws + WS_STR + (typ == 0 ? ST_CB : (typ == 1 ? ST_GA : ST_GB)));
                const float* gb = ep[0] + l * 2048 + (typ == 2 ? 1024 : 0);
#pragma unroll
                for (int bj = 0; bj < 2; ++bj) { const int c0 = cb0 + bj * 128 + cl;
                    float bb[8] = {0, 0, 0, 0, 0, 0, 0, 0};
                    if (typ != 0) LOAD8F(bb, gb + c0)
                    ROWS_LOOP { const int row = ROW_OF(ai, m); const float s = sv[ai * 4 + m]; ACC8(bj)
#pragma unroll
                        for (int j = 0; j < 8; ++j) { v[j] *= s; if (typ != 0) v[j] = sigm(v[j] + bb[j]); }
                        *(GAS u32x4*)(dst + (size_t)row * 1024 + c0) = pack8(v); } }
            }
        }
        else if constexpr (mode == EM_M1) { bf16_t* gbp = (bf16_t*)(ws + WS_STR + ST_GB);
#pragma unroll
            for (int ai = 0; ai < 2; ++ai) { u32x4 gr[4][2];
#pragma unroll
                for (int m = 0; m < 4; ++m)
#pragma unroll
                    for (int bj = 0; bj < 2; ++bj) gr[m][bj] = *(const GAS u32x4*)(gbp + (size_t)ROW_OF(ai, m) * 1024 + u.pn * 256 + bj * 128 + cl);
#pragma unroll
                for (int m = 0; m < 4; ++m)
#pragma unroll
                    for (int bj = 0; bj < 2; ++bj) { ACC8(bj) float g[8]; unpack8(gr[m][bj], g);
#pragma unroll
                        for (int j = 0; j < 8; ++j) v[j] *= g[j];
                        *(GAS u32x4*)(gbp + (size_t)ROW_OF(ai, m) * 1024 + u.pn * 256 + bj * 128 + cl) = pack8(v); }
                memclob(); }
        }
        else if constexpr (mode == EM_MG) { bf16_t* gap = (bf16_t*)(ws + WS_STR + ST_GA); const bf16_t* m1 = (const bf16_t*)(ws + WS_STR + ST_GB);
#pragma unroll
            for (int ai = 0; ai < 2; ++ai)
#pragma unroll
                for (int bj = 0; bj < 2; ++bj) { u32x4 gr[4], mr[4];
#pragma unroll
                    for (int m = 0; m < 4; ++m) { const size_t o = (size_t)ROW_OF(ai, m) * 1024 + u.pn * 256 + bj * 128 + cl; gr[m] = *(const GAS u32x4*)(gap + o); mr[m] = *(const GAS u32x4*)(m1 + o); }
#pragma unroll
                    for (int m = 0; m < 4; ++m) { ACC8(bj) const size_t o = (size_t)ROW_OF(ai, m) * 1024 + u.pn * 256 + bj * 128 + cl; float g[8], mm[8]; unpack8(gr[m], g); unpack8(mr[m], mm);
#pragma unroll
                        for (int j = 0; j < 8; ++j) v[j] = v[j] * g[j] + mm[j];
                        *(GAS u32x4*)(gap + o) = pack8(v); }
                    memclob(); }
        }
        else if constexpr (mode == EM_RES) { bf16_t* xb = (bf16_t*)(ws + WS_XB); float* ssb = (float*)(ws + WS_SSBP); const float* xsrc = ep[0];
#pragma unroll
            for (int ai = 0; ai < 2; ++ai) { float ss[4] = {0.f, 0.f, 0.f, 0.f};
#pragma unroll
                for (int bj = 0; bj < 2; ++bj) { f32x4 xa[4], xc[4]; u32x4 xr[4];
                    if (xsrc != nullptr) {
#pragma unroll
                        for (int m = 0; m < 4; ++m) { const GAS f32x4* xp = (const GAS f32x4*)(xsrc + (size_t)ROW_OF(ai, m) * 1024 + u.pn * 256 + bj * 128 + cl); xa[m] = xp[0]; xc[m] = xp[1]; }
                    } else {
#pragma unroll
                        for (int m = 0; m < 4; ++m) xr[m] = *(const GAS u32x4*)(xb + (size_t)ROW_OF(ai, m) * 1024 + u.pn * 256 + bj * 128 + cl);
#pragma unroll
                        for (int m = 0; m < 4; ++m) { float t8[8]; unpack8(xr[m], t8); xa[m] = (f32x4){t8[0], t8[1], t8[2], t8[3]}; xc[m] = (f32x4){t8[4], t8[5], t8[6], t8[7]}; }
                    }
#pragma unroll
                    for (int m = 0; m < 4; ++m) { ACC8(bj) const size_t o = (size_t)ROW_OF(ai, m) * 1024 + u.pn * 256 + bj * 128 + cl;
                        v[0] += xa[m][0]; v[1] += xa[m][1]; v[2] += xa[m][2]; v[3] += xa[m][3]; v[4] += xc[m][0]; v[5] += xc[m][1]; v[6] += xc[m][2]; v[7] += xc[m][3];
                        const u32x4 pw = pack8(v); *(GAS u32x4*)(xb + o) = pw;
                        float r8[8]; unpack8(pw, r8);
#pragma unroll
                        for (int j = 0; j < 8; ++j) ss[m] += r8[j] * r8[j]; }
                    memclob(); }
                if (want_ss) {
#pragma unroll
                    for (int m = 0; m < 4; ++m) { float s_ = ss[m]; s_ += __shfl_xor(s_, 16); s_ += __shfl_xor(s_, 32); if (fq == 0) *(GAS float*)(ssb + (size_t)ROW_OF(ai, m) * 16 + u.pn * 4 + wc) = s_; } } }
        }
        else if constexpr (mode == EM_Q) { bf16_t* q = (bf16_t*)(ws + WS_P1); const float* ssb = (const float*)(ws + WS_SSBP);
            float sv[8];
#pragma unroll
            for (int ai = 0; ai < 2; ++ai) { f32x4 sp[4][4];
#pragma unroll
                for (int m = 0; m < 4; ++m)
#pragma unroll
                    for (int x = 0; x < 4; ++x) sp[m][x] = *((const GAS f32x4*)(ssb + (size_t)ROW_OF(ai, m) * 16) + x);
#pragma unroll
                for (int m = 0; m < 4; ++m) { const f32x4 s0 = sp[m][0], s1 = sp[m][1], s2 = sp[m][2], s3 = sp[m][3];
                    const float sst = ((s0[0] + s0[1]) + (s0[2] + s0[3])) + ((s1[0] + s1[1]) + (s1[2] + s1[3])) + (((s2[0] + s2[1]) + (s2[2] + s2[3])) + ((s3[0] + s3[1]) + (s3[2] + s3[3])));
                    sv[ai * 4 + m] = rsqrtf(sst * (1.0f / 1024.0f) + RMS_EPS); } }
            ROWS_LOOP { const int row = ROW_OF(ai, m); const float s = sv[ai * 4 + m];
#pragma unroll
                for (int bj = 0; bj < 2; ++bj) { ACC8(bj)
#pragma unroll
                    for (int j = 0; j < 8; ++j) v[j] *= s;
                    *(GAS u32x4*)(q + (size_t)row * 1024 + u.pn * 256 + bj * 128 + cl) = pack8(v); } }
        }
        else if constexpr (mode == EM_ATTS) {
            bf16_t* pb = (bf16_t*)(ws + WS_STR + ST_PB); float* rinv = (float*)(ws + WS_SMALL + SM_RINV);
            LAS float* XM = (LAS float*)xlds; LAS float* XS = XM + 1024;
            float mx[8];
#pragma unroll
            for (int r8 = 0; r8 < 8; ++r8) { const int ai = r8 >> 2, m = r8 & 3; float t = -3.0e38f;
#pragma unroll
                for (int bj = 0; bj < 2; ++bj) { const f32x4 a0 = acc[ai][bj][m][0], a1 = acc[ai][bj][m][1]; t = fmaxf(t, fmaxf(fmaxf(fmaxf(a0[0], a0[1]), fmaxf(a0[2], a0[3])), fmaxf(fmaxf(a1[0], a1[1]), fmaxf(a1[2], a1[3])))); }
                t = fmaxf(t, __shfl_xor(t, 16)); t = fmaxf(t, __shfl_xor(t, 32)); mx[r8] = t;
                if (fq == 0) XM[(ai * 128 + wr * 64 + m * 16 + fr) * 4 + wc] = t; }
            asm volatile("s_waitcnt lgkmcnt(0)" ::: "memory"); __builtin_amdgcn_s_barrier(); asm volatile("" ::: "memory");
            float sm[8];
#pragma unroll
            for (int r8 = 0; r8 < 8; ++r8) { const int ai = r8 >> 2, m = r8 & 3; const int rl = ai * 128 + wr * 64 + m * 16 + fr; const f32x4 q4 = *(const LAS f32x4*)(XM + rl * 4);
                const float rm = fmaxf(fmaxf(q4[0], q4[1]), fmaxf(q4[2], q4[3])); float s_ = 0.f; const int row = ROW_OF(ai, m);
#pragma unroll
                for (int bj = 0; bj < 2; ++bj) { const f32x4 a0 = acc[ai][bj][m][0], a1 = acc[ai][bj][m][1];
                    float p[8] = {__expf(a0[0] - rm), __expf(a0[1] - rm), __expf(a0[2] - rm), __expf(a0[3] - rm), __expf(a1[0] - rm), __expf(a1[1] - rm), __expf(a1[2] - rm), __expf(a1[3] - rm)};
                    const u32x4 w = pack8(p); float pr[8]; unpack8(w, pr);
#pragma unroll
                    for (int j = 0; j < 8; ++j) s_ += pr[j];
                    *(GAS u32x4*)(pb + ((size_t)row * 4 + u.pn) * 256 + bj * 128 + cl) = w; }
                s_ += __shfl_xor(s_, 16); s_ += __shfl_xor(s_, 32); sm[r8] = s_;
                if (fq == 0) XS[rl * 4 + wc] = s_; }
            asm volatile("s_waitcnt lgkmcnt(0)" ::: "memory"); __builtin_amdgcn_s_barrier(); asm volatile("" ::: "memory");
            if (wc == 0 && fq == 0) {
#pragma unroll
                for (int r8 = 0; r8 < 8; ++r8) { const int ai = r8 >> 2, m = r8 & 3; const int rl = ai * 128 + wr * 64 + m * 16 + fr; const f32x4 q4 = *(const LAS f32x4*)(XS + rl * 4);
                    *(GAS float*)(rinv + (size_t)ROW_OF(ai, m) * 4 + u.pn) = 1.0f / ((q4[0] + q4[1]) + (q4[2] + q4[3])); } }
            (void)mx; (void)sm;
        }
        else if constexpr (mode == EM_ATTO) { bf16_t* o = (bf16_t*)(ws + WS_P1 + 32 * MiB); const float* rinv = (const float*)(ws + WS_SMALL + SM_RINV);
#pragma unroll
            for (int ai = 0; ai < 2; ++ai) { float sv[4];
#pragma unroll
                for (int m = 0; m < 4; ++m) sv[m] = *(const GAS float*)(rinv + ROW_OF(ai, m) * 4 + u.pn);
#pragma unroll
                for (int m = 0; m < 4; (memclob(), ++m)) { const int row = ROW_OF(ai, m); const float s = sv[m];
#pragma unroll
                    for (int bj = 0; bj < 2; ++bj) { ACC8(bj)
#pragma unroll
                        for (int j = 0; j < 8; ++j) v[j] *= s;
                        *(GAS u32x4*)(o + (size_t)row * 1024 + u.pn * 256 + bj * 128 + cl) = pack8(v); } } }
        }
        else if constexpr (mode == EM_MOE1) { bf16_t* H = (bf16_t*)(ws + WS_H); const float* rs = (const float*)(ws + WS_SMALL + SM_ROWS);
            float sv[8];
#pragma unroll
            for (int r8 = 0; r8 < 8; ++r8) sv[r8] = *(const GAS float*)(rs + ROW_OF(r8 >> 2, r8 & 3));
            ROWS_LOOP { const int row = ROW_OF(ai, m); const float s = sv[ai * 4 + m];
                const f32x4 g0 = acc[ai][0][m][0], g1 = acc[ai][0][m][1], u0 = acc[ai][1][m][0], u1 = acc[ai][1][m][1];
                float g[8] = {g0[0], g0[1], g0[2], g0[3], g1[0], g1[1], g1[2], g1[3]}, uu[8] = {u0[0], u0[1], u0[2], u0[3], u1[0], u1[1], u1[2], u1[3]}, v[8];
#pragma unroll
                for (int j = 0; j < 8; ++j) { const float gg = g[j] * s; v[j] = gg * sigm(gg) * (uu[j] * s); }
                *(GAS u32x4*)(H + (size_t)row * 512 + u.pn * 128 + cl) = pack8(v); }
        }
        else if constexpr (mode == EM_MOE2) { bf16_t* Y = (bf16_t*)(ws + WS_XP); const float* rw = (const float*)(ws + WS_SMALL + SM_ROWW);
            float sv[8];
#pragma unroll
            for (int r8 = 0; r8 < 8; ++r8) sv[r8] = *(const GAS float*)(rw + ROW_OF(r8 >> 2, r8 & 3));
            ROWS_LOOP { const int row = ROW_OF(ai, m); const float s = sv[ai * 4 + m];
#pragma unroll
                for (int bj = 0; bj < 2; ++bj) { ACC8(bj)
#pragma unroll
                    for (int j = 0; j < 8; ++j) v[j] *= s;
                    *(GAS u32x4*)(Y + (size_t)row * 1024 + u.pn * 256 + bj * 128 + cl) = pack8(v); } }
        }
#undef ROWS_LOOP
#undef ROW_OF
#undef ACC8
#undef LOAD8F
    }
};

__device__ __forceinline__ void tconv_item(const float* src, int src_ld, int col0, const float* gain, float scale, bf16_t* dst, int dst_ld, int k0, int n0, LAS float* scr, int lane) {
    const int r = lane >> 3, c4 = (lane & 7) * 4;
    f32x4 v[8];
#pragma unroll
    for (int i = 0; i < 8; ++i) v[i] = *(const f32x4*)(src + (size_t)(k0 + 8 * i + r) * src_ld + col0 + n0 + c4);
#pragma unroll
    for (int i = 0; i < 8; ++i) { const int kk = 8 * i + r; float g = scale; if (gain) g *= gain[k0 + kk];
        LAS float* d = scr + kk * 33 + c4; d[0] = v[i][0] * g; d[1] = v[i][1] * g; d[2] = v[i][2] * g; d[3] = v[i][3] * g; }
    LDS_WAIT(); asm volatile("" ::: "memory");
    const int c = lane & 7;
#pragma unroll
    for (int j = 0; j < 4; ++j) { const int n = (lane >> 3) + 8 * j; const LAS float* s = scr + (8 * c) * 33 + n;
        u32x4 o; o.x = cvt_pk_bf16(s[0 * 33], s[1 * 33]); o.y = cvt_pk_bf16(s[2 * 33], s[3 * 33]); o.z = cvt_pk_bf16(s[4 * 33], s[5 * 33]); o.w = cvt_pk_bf16(s[6 * 33], s[7 * 33]);
        *(u32x4*)(dst + (size_t)(n0 + n) * dst_ld + k0 + 8 * c) = o; }
    LDS_WAIT(); asm volatile("" ::: "memory");
}
struct Seg { const float* src; const float* gain; bf16_t* dst; int src_ld, col0, ncols, K, dst_ld; float scale; };
constexpr int NSEG_MAX = 40;
__device__ __forceinline__ void conv_layer_weights(const Ctx& C, int l, LAS unsigned char* lds) {
    Seg* tab = (Seg*)((unsigned char*)lds + 122880); int* pre = (int*)((unsigned char*)lds + 122880 + NSEG_MAX * sizeof(Seg)); int* nsegp = pre + NSEG_MAX + 1;
    __syncthreads();
    if (C.tid == 0) {
        int n = 0; int items = 0;
        const float* W = CIN(3) + (size_t)l * 1024 * INC; const float* nm = CIN(2) + l * 1024;
        bf16_t* w1a = WSP(bf16_t, WS_WGT + WG_W1A); bf16_t* w1b = WSP(bf16_t, WS_WGT + WG_W1B);
#define ADDSEG(S_, G_, D_, LD_, C0_, NC_, K_, DLD_, SC_) do { Seg s; s.src = (S_); s.gain = (G_); s.dst = (D_); s.src_ld = (LD_); s.col0 = (C0_); s.ncols = (NC_); s.K = (K_); s.dst_ld = (DLD_); s.scale = (SC_); \
        tab[n] = s; pre[n] = items; items += ((K_) / 64) * ((NC_) / 32); ++n; } while (0)
        ADDSEG(W, nm, w1a, INC, 0, 3072, 1024, 1024, 1.f);
        ADDSEG(W, nm, w1a + 3072 * 1024, INC, 3072, 64, 1024, 1024, 1.f);
        ADDSEG(W, nm, w1a + 3136 * 1024, INC, 3136, 64, 1024, 1024, 1.f);
        ADDSEG(W, nm, w1a + 3328 * 1024, INC, 3200, 160, 1024, 1024, 1.f);
        if (l == 1) ADDSEG(CIN(5), nm, w1a + 3200 * 1024, 32, 0, 32, 1024, 1024, 1.f);
        for (int q = 0; q < 8; ++q) { ADDSEG(W, nm, w1b + (size_t)(256 * q) * 1024, INC, 3360 + 128 * q, 128, 1024, 1024, 1.f); ADDSEG(W, nm, w1b + (size_t)(256 * q + 128) * 1024, INC, 3360 + 2048 + 128 * q, 128, 1024, 1024, 1.f); }
        ADDSEG(W, nm, w1b + (size_t)2048 * 1024, INC, 3360 + 1024, 1024, 1024, 1024, 1.f);
        ADDSEG(W, nm, w1b + (size_t)3072 * 1024, INC, 6432, 1024, 1024, 1024, 1.f);
        ADDSEG(W, nm, w1b + (size_t)4096 * 1024, INC, 7456, 1024, 1024, 1024, 1.f);
        ADDSEG(CIN(21) + (size_t)l * 1048576, nullptr, WSP(bf16_t, WS_WGT + WG_WBA), 1024, 0, 1024, 1024, 1024, 1.f);
        ADDSEG(CIN(22) + (size_t)l * 1048576, nullptr, WSP(bf16_t, WS_WGT + WG_WBB), 1024, 0, 1024, 1024, 1024, 1.f);
        ADDSEG(CIN(23) + (size_t)l * 1048576, nullptr, WSP(bf16_t, WS_WGT + WG_WMO), 1024, 0, 1024, 1024, 1024, 1.f);
        ADDSEG(CIN(26) + (size_t)l * 1048576, CIN(24) + l * 1024, WSP(bf16_t, WS_WGT + WG_WQ), 1024, 0, 1024, 1024, 1024, 0.0625f);
        ADDSEG(CIN(28) + (size_t)l * 1048576, nullptr, WSP(bf16_t, WS_WGT + WG_WO), 1024, 0, 1024, 1024, 1024, 1.f);
#undef ADDSEG
        pre[n] = items; *nsegp = n;
    }
    __syncthreads();
    const int nseg = *nsegp, total = pre[nseg];
    LAS float* scr = (LAS float*)(lds + C.wave * 8704);
    const int gw = C.bid * 8 + C.wave, NGW = C.G * 8;
    for (int it = gw; it < total; it += NGW) {
        int s = 0;
        for (int j = 1; j < nseg; ++j) if (it >= pre[j]) s = j;
        const Seg sg = tab[s]; const int r = it - pre[s], nblk = sg.ncols / 32, kb = r / nblk, nb = r % nblk;
        tconv_item(sg.src, sg.src_ld, sg.col0, sg.gain, sg.scale, sg.dst, sg.dst_ld, 64 * kb, 32 * nb, scr, C.lane);
    }
    const int gt = C.bid * 512 + C.tid, NGT = C.G * 512;
    { bf16_t* w1a = WSP(bf16_t, WS_WGT + WG_W1A); const int z0 = (l == 1) ? 3232 : 3200;
        const int nz = (3328 - z0) + 96;
        for (int i = gt; i < nz * 128; i += NGT) { const int rr = i / 128, cc = i % 128; const int row = rr < (3328 - z0) ? z0 + rr : 3488 + (rr - (3328 - z0)); *(u32x4*)(w1a + (size_t)row * 1024 + cc * 8) = (u32x4){0u, 0u, 0u, 0u}; } }
    { bf16_t* wx1 = WSP(bf16_t, WS_WGT + WG_WX1); const float* du = CIN(8) + (size_t)l * 64 * 1024; const float* au = CIN(10) + (size_t)l * 64 * 1024; const float* vu = CIN(13);
        for (int i = gt; i < 3072 * 256; i += NGT) { const int n = i >> 8, k = i & 255, typ = n >> 10, nn = n & 1023; float v = 0.f;
            if (typ == 0) { if (k < 64) v = du[k * 1024 + nn]; } else if (typ == 1) { if (k >= 64 && k < 128) v = au[(k - 64) * 1024 + nn]; } else { if (l == 1 && k >= 128 && k < 160) v = vu[(k - 128) * 1024 + nn]; }
            wx1[i] = (bf16_t)(cvt_pk_bf16(v, 0.f) & 0xffffu); }
        bf16_t* wx2 = WSP(bf16_t, WS_WGT + WG_WX2); const float* gu = CIN(11) + (size_t)l * 160 * 1024;
        for (int i = gt; i < 1024 * 256; i += NGT) { const int n = i >> 8, k = i & 255; const float v = k < 160 ? gu[k * 1024 + n] : 0.f; wx2[i] = (bf16_t)(cvt_pk_bf16(v, 0.f) & 0xffffu); } }
}
__device__ __forceinline__ void conv_expert_weights(const Ctx& C, int l, LAS unsigned char* lds) {
    LAS float* scr = (LAS float*)(lds + C.wave * 8704);
    const int gw = C.bid * 8 + C.wave, NGW = C.G * 8;
    const float* nf = CIN(29) + l * 1024;
    for (int it = gw; it < 16 * 768; it += NGW) {
        const int e = it / 768, r = it % 768;
        if (r < 512) { const int kb = r >> 5, nb = r & 31, n0 = 32 * nb, q = n0 >> 8, within = n0 & 255, which = within >> 7, hid = q * 128 + (within & 127);
            const float* src = (which ? CIN(35) : CIN(34)) + ((size_t)l * 16 + e) * 1024 * 512;
            tconv_item(src, 512, hid, nf, 1.f, WSP(bf16_t, WS_WE1) + ((size_t)e * 1024 + n0) * 1024, 1024, 64 * kb, 0, scr, C.lane);
        } else { const int r2 = r - 512, kb = r2 >> 5, nb = r2 & 31;
            const float* src = CIN(36) + ((size_t)l * 16 + e) * 512 * 1024;
            tconv_item(src, 1024, 0, nullptr, 1.f, WSP(bf16_t, WS_WE2) + (size_t)e * 1024 * 512, 512, 64 * kb, 32 * nb, scr, C.lane); }
    }
}
__device__ __forceinline__ void phase_prologue(const Ctx& C, LAS unsigned char* lds) {
    const int gw = C.bid * 8 + C.wave, NGW = C.G * 8, lane = C.lane;
    float* ssa = WSP(float, WS_SMALL + SM_SSA); bf16_t* xb = WSP(bf16_t, WS_XB);
    for (int m = gw; m < NT; m += NGW) {
        const f32x4* xr = (const f32x4*)(CIN(0) + (size_t)m * 1024) + lane; u32x2* b = (u32x2*)(xb + (size_t)m * 1024) + lane;
        float s = 0.f;
#pragma unroll
        for (int j = 0; j < 4; ++j) { const f32x4 v = xr[64 * j]; s += v[0] * v[0] + v[1] * v[1] + v[2] * v[2] + v[3] * v[3]; b[64 * j] = (u32x2){cvt_pk_bf16(v[0], v[1]), cvt_pk_bf16(v[2], v[3])}; }
        s = wave_sum(s); if (lane == 0) ssa[m] = s;
    }
    for (int m = gw; m < 2048; m += NGW) {
        const f32x4* xr = (const f32x4*)(CIN(1) + (size_t)m * 1024) + lane; f32x4 v[4]; float s = 0.f;
#pragma unroll
        for (int j = 0; j < 4; ++j) { v[j] = xr[64 * j]; s += v[j][0] * v[j][0] + v[j][1] * v[j][1] + v[j][2] * v[j][2] + v[j][3] * v[j][3]; }
        s = rsqrtf(wave_sum(s) * (1.0f / 1024.0f) + RMS_EPS);
#pragma unroll
        for (int l = 0; l < 2; ++l) { const f32x4* g = (const f32x4*)(CIN(25) + l * 1024) + lane; u32x2* b = (u32x2*)(WSP(bf16_t, WS_STR + ST_MN) + (size_t)l * 2048 * 1024 + (size_t)m * 1024) + lane;
#pragma unroll
            for (int j = 0; j < 4; ++j) { const f32x4 gg = g[64 * j]; b[64 * j] = (u32x2){cvt_pk_bf16(v[j][0] * s * gg[0], v[j][1] * s * gg[1]), cvt_pk_bf16(v[j][2] * s * gg[2], v[j][3] * s * gg[3])}; } }
    }
    { LAS float* scr = (LAS float*)(lds + C.wave * 8704);
        for (int it = gw; it < 2 * 16 * 64; it += NGW) { const int l = it >> 10, r = it & 1023, kb = r >> 6, nb = r & 63;
            tconv_item(CIN(27) + (size_t)l * 1024 * 2048, 2048, 0, nullptr, 1.f, WSP(bf16_t, WS_STR + ST_WKVT) + (size_t)l * 2048 * 1024, 1024, 64 * kb, 32 * nb, scr, lane); } }
    conv_layer_weights(C, 0, lds);
}
__device__ __forceinline__ void phase_prescan(const Ctx& C, int l) {
    const int lane = C.lane, rg = lane >> 3, cg = lane & 7;
    bf16_t* p1 = WSP(bf16_t, WS_P1); const bf16_t* halo = WSP(bf16_t, WS_HALO); bf16_t* VF = WSP(bf16_t, WS_VF);
    const float* mu_in = CIN(4) + l * 3360; const float* mu_v = CIN(6);
    const int gw = C.bid * 8 + C.wave, NGW = C.G * 8;
    for (int wu = gw; wu < 64 * 24; wu += NGW) {
        const int pm = wu / 24, s = 32 + (wu % 24);
        int act = 0, mui = -1; bool active = true;
        const int c8 = cg * 8;
        if (s < 48) mui = s * 64 + c8;
        else if (s == 48) { act = 1; mui = 3072 + c8; }
        else if (s == 49) { mui = 3136 + c8; }
        else if (s == 50) { if (l == 1 && cg < 4) mui = -2; else active = false; }
        else if (s == 52 || s == 53) { act = 2; mui = 3200 + (s - 52) * 64 + c8; }
        else if (s == 54) { if (cg < 4) { act = 2; mui = 3200 + 128 + c8; } else active = false; }
        else active = false;
        if (!active) continue;
        float mu[8];
        { const float* mp = (mui == -2) ? mu_v + c8 : mu_in + mui; const f32x4 a = *(const GAS f32x4*)mp, b = *(const GAS f32x4*)(mp + 4); mu[0] = a[0]; mu[1] = a[1]; mu[2] = a[2]; mu[3] = a[3]; mu[4] = b[0]; mu[5] = b[1]; mu[6] = b[2]; mu[7] = b[3]; }
        const bool isv = (s < 48);
        const int col = s * 64 + c8, r0 = pm * 256 + rg * 32;
        u32x4 praw;
        if (rg == 0) { if ((pm & 7) == 0) praw = (u32x4){0u, 0u, 0u, 0u}; else praw = *(const GAS u32x4*)(halo + (size_t)(pm - 1) * LD1 + col); }
        else praw = *(const GAS u32x4*)(p1 + (size_t)(r0 - 1) * LD1 + col);
        u32x4 raw[8];
#pragma unroll
        for (int i = 0; i < 8; ++i) raw[i] = *(const GAS u32x4*)(p1 + (size_t)(r0 + i) * LD1 + col);
        asm volatile("s_waitcnt vmcnt(0)" ::: "memory");
        float prev[8]; unpack8(praw, prev);
#pragma unroll 1
        for (int bt = 0; bt < 4; ++bt) {
            u32x4 nxt[8];
            if (bt < 3) {
#pragma unroll
                for (int i = 0; i < 8; ++i) nxt[i] = *(const GAS u32x4*)(p1 + (size_t)(r0 + 8 * (bt + 1) + i) * LD1 + col); }
#pragma unroll
            for (int i = 0; i < 8; ++i) { const int row = r0 + 8 * bt + i; float cur[8], o[8]; unpack8(raw[i], cur);
#pragma unroll
                for (int j = 0; j < 8; ++j) { float v = cur[j] + (prev[j] - cur[j]) * mu[j]; if (act == 1) v = tanhf(v); else if (act == 2) v = sigm(v); o[j] = v; prev[j] = cur[j]; }
                const u32x4 w = pack8(o); *(GAS u32x4*)(p1 + (size_t)row * LD1 + col) = w;
                if (isv && l == 0) *(GAS u32x4*)(VF + (size_t)row * 1024 + (s - 32) * 64 + c8) = w; }
            if (bt < 3) {
#pragma unroll
                for (int i = 0; i < 8; ++i) raw[i] = nxt[i]; }
        }
    }
}
typedef short bf16x4 __attribute__((ext_vector_type(4)));
#define MFMA16(a, b, c) __builtin_amdgcn_mfma_f32_16x16x16bf16_1k((a), (b), (c), 0, 0, 0)
#define MFMA32(a, b, c) __builtin_amdgcn_mfma_f32_16x16x32_bf16((a), (b), (c), 0, 0, 0)
__device__ __forceinline__ bf16x4 pk4(const f32x4 v) { u32x2 w; w.x = cvt_pk_bf16(v[0], v[1]); w.y = cvt_pk_bf16(v[2], v[3]); return __builtin_bit_cast(bf16x4, w); }
__device__ __forceinline__ f32x4 up4(const bf16x4 h) { const u32x2 w = __builtin_bit_cast(u32x2, h); return (f32x4){bflo(w.x), bfhi(w.x), bflo(w.y), bfhi(w.y)}; }
__device__ __forceinline__ f32x4 addI(f32x4 v, int i, int q) {
#pragma unroll
    for (int e = 0; e < 4; ++e) v[e] += (4 * q + e == i) ? 1.0f : 0.0f;
    return v; }
__device__ __forceinline__ void scat8(LAS unsigned char* mat, int row0, int col, const u32x4 p) {
    LAS bf16_t* m = (LAS bf16_t*)mat; const unsigned wv[4] = {p.x, p.y, p.z, p.w};
#pragma unroll
    for (int j = 0; j < 8; ++j) m[(row0 + j) * 72 + col] = (bf16_t)((j & 1) ? (wv[j >> 1] >> 16) : (wv[j >> 1] & 0xffffu)); }
constexpr int SMB = 64 * 144;
enum { M_At = 0, M_Rt, M_Bm, M_Km, M_AtT, M_VT, M_BtT, M_KtT, M_Aab, M_AabT, M_Aak, M_Arb, M_Ark, M_ApT = M_Bm, M_VpT = M_Km };
constexpr size_t WS_BON = 33 * MiB;
constexpr size_t WS_BND = 34 * MiB;
#define SMAT(m) (lds + (m) * SMB)
#define LDS4(p) (*(const LAS bf16x4*)(p))
#define LDS8(p) (*(const LAS bf16x8*)(p))
__device__ __forceinline__ void settle(f32x4& a) { asm volatile("s_nop 7\n\ts_nop 7" : "+v"(a)); }
__device__ __forceinline__ f32x4 tile64(const LAS unsigned char* X, const LAS unsigned char* Y, int mb, int nb, int i, int q, f32x4 acc) {
    acc = MFMA32(LDS8(Y + (16 * nb + i) * 144 + (8 * q) * 2), LDS8(X + (16 * mb + i) * 144 + (8 * q) * 2), acc);
    acc = MFMA32(LDS8(Y + (16 * nb + i) * 144 + (8 * q + 32) * 2), LDS8(X + (16 * mb + i) * 144 + (8 * q + 32) * 2), acc);
    settle(acc);
    return acc; }
#define LBAR() do { asm volatile("s_waitcnt lgkmcnt(0)" ::: "memory"); __builtin_amdgcn_s_barrier(); asm volatile("" ::: "memory"); } while (0)
__device__ __forceinline__ void phase_scanA(const Ctx& C, int l, LAS unsigned char* lds) {
    const int tid = C.tid, lane = C.lane, w = C.wave, i = lane & 15, q = lane >> 4;
    const int tt = tid >> 3, c8 = (tid & 7) * 8;
    bf16_t* p1 = WSP(bf16_t, WS_P1); bf16_t* WEp = WSP(bf16_t, WS_STR + ST_WE); bf16_t* AAp = WSP(bf16_t, WS_STR + ST_AA); bf16_t* KKp = WSP(bf16_t, WS_STR + ST_KK); float* BON = WSP(float, WS_BON);
    LAS float* LW = (LAS float*)(lds + 8 * SMB); LAS float* W63 = (LAS float*)(lds + 13 * SMB); LAS float* GT = W63 + 64; LAS float* RK = GT + 512; LAS float* CT = RK + 1024;
    const float* rkp = CIN(16) + l * 1024;
    const f32x4 z4 = (f32x4){0.f, 0.f, 0.f, 0.f};
    u32x4 in_r, in_k, in_v, in_we, in_aa, in_rp, in_kp;
    const float* mup = CIN(4) + l * 3360; const float* kkg = CIN(14) + l * 1024; const float* kag = CIN(15) + l * 1024;
    const unsigned offp = (unsigned)(tt * LD1 + c8) * 2u, offs = (unsigned)(tt * 1024 + c8) * 2u;
#define SA_LOAD(uu) do { const int bh_ = (uu) >> 5, c_ = (uu) & 31; const size_t t0_ = (size_t)((bh_ >> 4) * TT + c_ * 64); const int h0_ = (bh_ & 15) * 64; \
        const char* bp_ = (const char*)(p1 + t0_ * LD1 + h0_); const char* bw_ = (const char*)(WEp + t0_ * 1024 + h0_); const char* ba_ = (const char*)(AAp + t0_ * 1024 + h0_); \
        in_r = *(const GAS u32x4*)(bp_ + offp); in_k = *(const GAS u32x4*)(bp_ + 2048 + offp); in_v = *(const GAS u32x4*)(bp_ + 4096 + offp); \
        in_we = *(const GAS u32x4*)(bw_ + offs); in_aa = *(const GAS u32x4*)(ba_ + offs); \
        if (tt == 0) { if (c_ == 0) { in_rp = (u32x4){0u, 0u, 0u, 0u}; in_kp = in_rp; } else { const bf16_t* bq_ = WSP(bf16_t, WS_BND) + ((t0_ - 1) >> 6) * 2048 + h0_ + c8; in_rp = *(const GAS u32x4*)bq_; in_kp = *(const GAS u32x4*)(bq_ + 1024); } } \
        else { in_rp = *(const GAS u32x4*)(bp_ + offp - LD1 * 2); in_kp = *(const GAS u32x4*)(bp_ + 2048 + offp - LD1 * 2); } } while (0)
    constexpr int NU = 4096;
    for (int x = tid; x < 1024; x += 512) { RK[x] = rkp[x]; CT[x] = mup[x]; CT[1024 + x] = mup[1024 + x]; CT[2048 + x] = kkg[x]; CT[3072 + x] = kag[x]; }
    LBAR();
    int u = C.bid;
    if (u < NU) SA_LOAD(u);
    for (; u < NU; u += C.G) {
        const int bh = u >> 5, c = u & 31, b = bh >> 4, h = bh & 15, tok0 = b * TT + c * 64, hc = h * 64;

        float r[8], k[8], we[8], aa[8], kk[8];
        asm volatile("" : "+v"(in_r), "+v"(in_k), "+v"(in_v), "+v"(in_we), "+v"(in_aa), "+v"(in_rp), "+v"(in_kp));
        unpack8(in_r, r); unpack8(in_k, k); unpack8(in_we, we); unpack8(in_aa, aa);
        {
            float rp[8], kp[8]; unpack8(in_rp, rp); unpack8(in_kp, kp);
            float mur[8], muk[8], kkc[8], kac[8];
#pragma unroll
            for (int hh = 0; hh < 2; ++hh) { const f32x4 c0 = *(const LAS f32x4*)(CT + hc + c8 + 4 * hh), c1 = *(const LAS f32x4*)(CT + 1024 + hc + c8 + 4 * hh), c2 = *(const LAS f32x4*)(CT + 2048 + hc + c8 + 4 * hh), c3 = *(const LAS f32x4*)(CT + 3072 + hc + c8 + 4 * hh);
#pragma unroll
                for (int j = 0; j < 4; ++j) { mur[4 * hh + j] = c0[j]; muk[4 * hh + j] = c1[j]; kkc[4 * hh + j] = c2[j]; kac[4 * hh + j] = c3[j]; } }
            float ssq = 0.f;
#pragma unroll
            for (int j = 0; j < 8; ++j) { r[j] = r[j] + (rp[j] - r[j]) * mur[j]; k[j] = k[j] + (kp[j] - k[j]) * muk[j]; kk[j] = k[j] * kkc[j]; ssq += kk[j] * kk[j]; }
            ssq = sum8(ssq);
            const float inv = 1.0f / fmaxf(sqrtf(ssq), 1e-12f);
#pragma unroll
            for (int j = 0; j < 8; ++j) { kk[j] = kk[j] * inv; k[j] = k[j] * (1.0f + (aa[j] - 1.0f) * kac[j]); }
        }
        const u32x4 vraw = in_v;
        if (u + C.G < NU) SA_LOAD(u + C.G);
#pragma unroll
        for (int j = 0; j < 8; ++j) LW[tt * 68 + c8 + j] = -we[j];
        LBAR();
        { const int g = tid >> 6, kx = tid & 63; float cs_[8]; float run = 0.f;
#pragma unroll
            for (int n = 0; n < 8; ++n) { run += LW[(8 * g + n) * 68 + kx]; cs_[n] = run; }
            GT[g * 64 + kx] = run;
            LBAR();
            float off = 0.f;
#pragma unroll
            for (int gg = 0; gg < 7; ++gg) off += (gg < g) ? GT[gg * 64 + kx] : 0.f;
#pragma unroll
            for (int n = 0; n < 8; ++n) LW[(8 * g + n) * 68 + kx] = cs_[n] + off; }
        LBAR();
        {
            float at[8], rt[8], bm[8], km[8], bt[8], kt[8]; float bon = 0.f, e63[8];
            float Lv[8], Lm[8], Lev[8], rkv[8];
            { const f32x4 a0 = *(const LAS f32x4*)(LW + tt * 68 + c8), a1 = *(const LAS f32x4*)(LW + tt * 68 + c8 + 4), e0 = *(const LAS f32x4*)(LW + 63 * 68 + c8), e1 = *(const LAS f32x4*)(LW + 63 * 68 + c8 + 4);
                const f32x4 r0 = *(const LAS f32x4*)(RK + hc + c8), r1 = *(const LAS f32x4*)(RK + hc + c8 + 4);
                f32x4 m0 = (f32x4){0.f, 0.f, 0.f, 0.f}, m1 = m0; if (tt) { m0 = *(const LAS f32x4*)(LW + (tt - 1) * 68 + c8); m1 = *(const LAS f32x4*)(LW + (tt - 1) * 68 + c8 + 4); }
#pragma unroll
                for (int j = 0; j < 4; ++j) { Lv[j] = a0[j]; Lv[4 + j] = a1[j]; Lev[j] = e0[j]; Lev[4 + j] = e1[j]; Lm[j] = m0[j]; Lm[4 + j] = m1[j]; rkv[j] = r0[j]; rkv[4 + j] = r1[j]; } }
#pragma unroll
            for (int j = 0; j < 8; ++j) {
                const float L = Lv[j], Lm1 = Lm[j], Le = Lev[j];
                const float eL = __expf(L), eLm1 = __expf(Lm1), einv = __builtin_amdgcn_rcpf(eL), eend = __expf(Le) * einv, bv = kk[j] * aa[j];
                at[j] = -kk[j] * eLm1; rt[j] = r[j] * eL; bm[j] = bv * einv; km[j] = k[j] * einv; bt[j] = bv * eend; kt[j] = k[j] * eend;
                bon += r[j] * k[j] * rkv[j]; e63[j] = eL;
            }
            bon = sum8(bon);
            if ((tid & 7) == 0) *(GAS float*)(BON + (size_t)(tok0 + tt) * 16 + h) = bon;
            if (tt == 63) {
#pragma unroll
                for (int j = 0; j < 8; ++j) W63[c8 + j] = e63[j]; }
            *(LAS u32x4*)(SMAT(M_At) + tt * 144 + c8 * 2) = pack8(at); *(LAS u32x4*)(SMAT(M_Rt) + tt * 144 + c8 * 2) = pack8(rt);
            *(LAS u32x4*)(SMAT(M_Bm) + tt * 144 + c8 * 2) = pack8(bm); *(LAS u32x4*)(SMAT(M_Km) + tt * 144 + c8 * 2) = pack8(km);
            *(LAS u32x4*)(SMAT(M_Aak) + tt * 144 + c8 * 2) = vraw; *(LAS u32x4*)(SMAT(M_Arb) + tt * 144 + c8 * 2) = pack8(bt); *(LAS u32x4*)(SMAT(M_Ark) + tt * 144 + c8 * 2) = pack8(kt);
        }
        LBAR();
        {
            const int tl = lane, ch0 = 8 * w;
            scat8(SMAT(M_AtT), ch0, tl, *(const LAS u32x4*)(SMAT(M_At) + tl * 144 + ch0 * 2)); scat8(SMAT(M_VT), ch0, tl, *(const LAS u32x4*)(SMAT(M_Aak) + tl * 144 + ch0 * 2));
            scat8(SMAT(M_BtT), ch0, tl, *(const LAS u32x4*)(SMAT(M_Arb) + tl * 144 + ch0 * 2)); scat8(SMAT(M_KtT), ch0, tl, *(const LAS u32x4*)(SMAT(M_Ark) + tl * 144 + ch0 * 2));
        }
        LBAR();
        {
            const int tb = w & 3; const bool incl = (w >= 4);
            const LAS unsigned char* X = SMAT(incl ? M_Rt : M_At);
            const bf16x8 xf0 = LDS8(X + (16 * tb + i) * 144 + (8 * q) * 2), xf1 = LDS8(X + (16 * tb + i) * 144 + (8 * q + 32) * 2);
#pragma unroll
            for (int nt = 0; nt < 8; ++nt) {
                const int jb = nt & 3; const bool isK = nt >= 4;
                const LAS unsigned char* Y = SMAT(isK ? M_Km : M_Bm);
                LAS unsigned char* O = SMAT(incl ? (isK ? M_Ark : M_Arb) : (isK ? M_Aak : M_Aab));
                f32x4 acc = z4;
                if (jb <= tb) {
                    acc = MFMA32(LDS8(Y + (16 * jb + i) * 144 + (8 * q) * 2), xf0, acc);
                    acc = MFMA32(LDS8(Y + (16 * jb + i) * 144 + (8 * q + 32) * 2), xf1, acc);
                    settle(acc);
                    if (jb == tb) {
#pragma unroll
                        for (int e = 0; e < 4; ++e) { const int jj = 4 * q + e; const bool keep = incl ? (jj <= i) : (jj < i); acc[e] = keep ? acc[e] : 0.f; } }
                }
                const bf16x4 pk = pk4(acc);
                *(LAS bf16x4*)(O + (16 * tb + i) * 144 + (16 * jb + 4 * q) * 2) = pk;
                if (!incl && !isK && jb == tb) { const u32x2 pw = __builtin_bit_cast(u32x2, pk); LAS bf16_t* T = (LAS bf16_t*)SMAT(M_AabT);
                    T[(16 * jb + 4 * q + 0) * 72 + 16 * tb + i] = (bf16_t)(pw.x & 0xffffu); T[(16 * jb + 4 * q + 1) * 72 + 16 * tb + i] = (bf16_t)(pw.x >> 16);
                    T[(16 * jb + 4 * q + 2) * 72 + 16 * tb + i] = (bf16_t)(pw.y & 0xffffu); T[(16 * jb + 4 * q + 3) * 72 + 16 * tb + i] = (bf16_t)(pw.y >> 16); }
            }
        }
        LBAR();
        {
            const int cs = 16 * (w & 3); const bool isA = (w < 4);
            f32x4 rhs[4];
            if (isA) {
                const int I = w;
                const bf16x4 nt_ = LDS4(SMAT(M_Aab) + (16 * I + i) * 144 + (16 * I + 4 * q) * 2);
                const bf16x4 nn_ = LDS4(SMAT(M_AabT) + (16 * I + i) * 144 + (16 * I + 4 * q) * 2);
                const bf16x4 e2n = pk4(MFMA16(nt_, nn_, z4)), e2t = pk4(MFMA16(nn_, nt_, z4));
                const bf16x4 e4n = pk4(MFMA16(e2t, e2n, z4)), e4t = pk4(MFMA16(e2n, e2t, z4));
                const f32x4 e8n = MFMA16(e4t, e4n, z4);
                const bf16x4 g2 = pk4(MFMA16(pk4(addI(up4(e4t), i, q)), pk4(addI(e8n, i, q)), z4));
                const bf16x4 g1t = pk4(MFMA16(pk4(addI(up4(e2n), i, q)), pk4(addI(up4(nt_), i, q)), z4));
                *(LAS bf16x4*)(SMAT(M_AabT) + (16 * I + i) * 144 + (16 * ((I + 1) & 3) + 4 * q) * 2) = pk4(MFMA16(g2, g1t, z4));
#pragma unroll
                for (int I2 = 0; I2 < 4; ++I2) rhs[I2] = up4(LDS4(SMAT(M_AtT) + (cs + i) * 144 + (16 * I2 + 4 * q) * 2));
            } else {
#pragma unroll
                for (int I2 = 0; I2 < 4; ++I2) { f32x4 acc = z4;
#pragma unroll
                    for (int J = 0; J <= I2; ++J) acc = MFMA16(LDS4(SMAT(M_Aak) + (16 * I2 + i) * 144 + (16 * J + 4 * q) * 2), LDS4(SMAT(M_VT) + (cs + i) * 144 + (16 * J + 4 * q) * 2), acc);
                    rhs[I2] = acc; }
            }
            LBAR();
            bf16x4 Xb[4];
            LAS unsigned char* XO = SMAT(isA ? M_ApT : M_VpT);
#pragma unroll
            for (int I = 0; I < 4; ++I) {
                f32x4 acc = rhs[I];
#pragma unroll
                for (int J = 0; J < I; ++J) acc = MFMA16(LDS4(SMAT(M_Aab) + (16 * I + i) * 144 + (16 * J + 4 * q) * 2), Xb[J], acc);
                const bf16x4 tal = LDS4(SMAT(M_AabT) + (16 * I + i) * 144 + (16 * ((I + 1) & 3) + 4 * q) * 2);
                Xb[I] = pk4(MFMA16(tal, pk4(acc), z4));
                *(LAS bf16x4*)(XO + (cs + i) * 144 + (16 * I + 4 * q) * 2) = Xb[I];
            }
        }
        LBAR();
        {
            const int mat = w >> 1;
            const LAS unsigned char* X1 = SMAT(mat == 0 ? M_BtT : (mat == 2 ? M_Arb : M_VpT));
            const LAS unsigned char* Y1 = SMAT(mat == 0 ? M_ApT : (mat == 1 ? M_BtT : (mat == 2 ? M_ApT : M_Arb)));
            const LAS unsigned char* X2 = SMAT(M_VT);
            const LAS unsigned char* Y2 = SMAT(mat == 1 ? M_KtT : M_Ark);
            const bool two = (mat == 1) || (mat == 3);
            bf16_t* dst = mat == 0 ? KKp : (mat == 1 ? WEp : (mat == 2 ? AAp : p1 + 1024)); const int ld = (mat == 3) ? LD1 : 1024;
#pragma unroll
            for (int mm = 0; mm < 2; ++mm) { const int mb = 2 * (w & 1) + mm;
                const bf16x8 xa0 = LDS8(X1 + (16 * mb + i) * 144 + (8 * q) * 2), xa1 = LDS8(X1 + (16 * mb + i) * 144 + (8 * q + 32) * 2);
                bf16x8 xb0 = xa0, xb1 = xa1;
                if (two) { xb0 = LDS8(X2 + (16 * mb + i) * 144 + (8 * q) * 2); xb1 = LDS8(X2 + (16 * mb + i) * 144 + (8 * q + 32) * 2); }
#pragma unroll
                for (int nb = 0; nb < 4; ++nb) {
                    f32x4 acc = z4;
                    acc = MFMA32(LDS8(Y1 + (16 * nb + i) * 144 + (8 * q) * 2), xa0, acc);
                    acc = MFMA32(LDS8(Y1 + (16 * nb + i) * 144 + (8 * q + 32) * 2), xa1, acc);
                    if (two) { acc = MFMA32(LDS8(Y2 + (16 * nb + i) * 144 + (8 * q) * 2), xb0, acc); acc = MFMA32(LDS8(Y2 + (16 * nb + i) * 144 + (8 * q + 32) * 2), xb1, acc); }
                    settle(acc);
                    if (mat == 0) {
#pragma unroll
                        for (int e = 0; e < 4; ++e) acc[e] += (16 * mb + i == 16 * nb + 4 * q + e) ? W63[16 * mb + i] : 0.f; }
                    else if (mat == 2) { const f32x4 rr = up4(LDS4(SMAT(M_Rt) + (16 * mb + i) * 144 + (16 * nb + 4 * q) * 2)); acc = acc + rr; }
                    *(GAS bf16x4*)(dst + (size_t)(tok0 + 16 * mb + i) * ld + hc + 16 * nb + 4 * q) = pk4(acc);
                } }
        }
        LBAR();
    }
#undef SA_LOAD
}
__device__ __forceinline__ void phase_scanB(const Ctx& C, int l, LAS unsigned char* lds) {
    const int tid = C.tid, lane = C.lane, w = C.wave, i = lane & 15, q = lane >> 4;
    bf16_t* p1 = WSP(bf16_t, WS_P1); const bf16_t* WEp = WSP(bf16_t, WS_STR + ST_WE); const bf16_t* AAp = WSP(bf16_t, WS_STR + ST_AA); const bf16_t* KKp = WSP(bf16_t, WS_STR + ST_KK); const bf16_t* OGp = WSP(bf16_t, WS_STR + ST_OG);
    const float* BON = WSP(float, WS_BON);
    LAS unsigned char* PTm = lds; LAS unsigned char* Rh = lds + SMB; LAS unsigned char* Gm = lds + 2 * SMB; LAS unsigned char* Y0m = lds + 3 * SMB;
    LAS unsigned char* SMALL0 = lds + 4 * SMB;
    LAS float* YX0 = (LAS float*)(lds + 4 * SMB + 2 * 16640);
    const bool loader = (w < 4);
    const int lt = tid & 255;
    const int row0 = lt >> 3, c16 = (lt & 7) * 8;
    const int ptt = lt >> 2, pc = (lt & 3) * 16;
    for (int u = C.bid; u < NBATCH * NHEAD; u += C.G) {
        const int b = u >> 4, h = u & 15, hc = h * 64;
        LAS float* LGB = YX0 + 2 * 4352;
        if (tid < 128) LGB[tid] = (tid < 64 ? CIN(17) : CIN(18))[l * 1024 + hc + (tid & 63)];
        u32x4 sa[12], sb[12]; float ba = 0.f, bbv = 0.f;
        const unsigned os0 = (unsigned)(row0 * 1024 + c16) * 2u, os1 = os0 + 32u * 1024u * 2u, op0 = (unsigned)(row0 * LD1 + c16) * 2u, op1 = op0 + 32u * LD1 * 2u;
#define SB_ISSUE(cc, S_, B_) do { const size_t t0_ = (size_t)(b * TT + (cc) * 64); \
            const char* bk_ = (const char*)(KKp + t0_ * 1024 + hc); const char* ba_ = (const char*)(AAp + t0_ * 1024 + hc); const char* bw_ = (const char*)(WEp + t0_ * 1024 + hc); const char* bo_ = (const char*)(OGp + t0_ * 1024 + hc); const char* bp_ = (const char*)(p1 + t0_ * LD1 + hc); \
            S_[0] = *(const GAS u32x4*)(bk_ + os0); S_[1] = *(const GAS u32x4*)(bk_ + os1); S_[2] = *(const GAS u32x4*)(ba_ + os0); S_[3] = *(const GAS u32x4*)(ba_ + os1); S_[4] = *(const GAS u32x4*)(bw_ + os0); S_[5] = *(const GAS u32x4*)(bw_ + os1); \
            S_[6] = *(const GAS u32x4*)(bp_ + 2048 + op0); S_[7] = *(const GAS u32x4*)(bp_ + 2048 + op1); S_[8] = *(const GAS u32x4*)(bp_ + 4096 + op0); S_[9] = *(const GAS u32x4*)(bp_ + 4096 + op1); S_[10] = *(const GAS u32x4*)(bo_ + os0); S_[11] = *(const GAS u32x4*)(bo_ + os1); \
            if (lt < 64) B_ = *(const GAS float*)(BON + (t0_ + lt) * 16 + h); } while (0)
#define SB_STAGE(cc, S_, B_) do { LAS unsigned char* sm_ = SMALL0 + ((cc) & 1) * 16640; _Pragma("unroll") for (int k2 = 0; k2 < 2; ++k2) { const int r_ = row0 + 32 * k2; \
            *(LAS u32x4*)(PTm + r_ * 144 + c16 * 2) = S_[0 + k2]; *(LAS u32x4*)(Rh + r_ * 144 + c16 * 2) = S_[2 + k2]; *(LAS u32x4*)(Gm + r_ * 144 + c16 * 2) = S_[4 + k2]; *(LAS u32x4*)(Y0m + r_ * 144 + c16 * 2) = S_[6 + k2]; \
            *(LAS u32x4*)(sm_ + r_ * 128 + c16 * 2) = S_[8 + k2]; *(LAS u32x4*)(sm_ + 8192 + r_ * 128 + c16 * 2) = S_[10 + k2]; } \
            if (lt < 64) ((LAS float*)(sm_ + 16384))[lt] = B_; } while (0)
        bf16x4 Sb[4];
#pragma unroll
        for (int cc = 0; cc < 4; ++cc) Sb[cc] = (bf16x4){0, 0, 0, 0};
        if (loader) { SB_ISSUE(0, sa, ba); SB_ISSUE(1, sb, bbv); }
#define SB_ITER(cc, S_, B_) do { \
        if (loader) { asm volatile("" : "+v"(S_[0]), "+v"(S_[1]), "+v"(S_[2]), "+v"(S_[3]), "+v"(S_[4]), "+v"(S_[5]), "+v"(S_[6]), "+v"(S_[7]), "+v"(S_[8]), "+v"(S_[9]), "+v"(S_[10]), "+v"(S_[11]), "+v"(B_)); \
            SB_STAGE(cc, S_, B_); if ((cc) + 2 < TT / 64) SB_ISSUE((cc) + 2, S_, B_); } \
        LBAR(); \
        if (loader) { \
            const LAS unsigned char* lb1 = lds + (i * 144 + q * 8); const LAS unsigned char* lb2 = lb1 + w * 2304; \
            LAS float* yb = YX0 + ((cc) & 1) * 4352 + (4 * q * 68 + 16 * w + i); \
            _Pragma("unroll") for (int tb = 0; tb < 4; ++tb) { \
                f32x4 acc = up4(LDS4(lb2 + 3 * SMB + tb * 32)); \
                _Pragma("unroll") for (int cc2 = 0; cc2 < 4; ++cc2) acc = MFMA16(LDS4(lb1 + SMB + tb * 2304 + cc2 * 32), Sb[cc2], acc); \
                _Pragma("unroll") for (int e = 0; e < 4; ++e) yb[(16 * tb + e) * 68] = acc[e]; memclob(); } \
            bf16x4 Sn[4]; \
            _Pragma("unroll") for (int cp = 0; cp < 4; ++cp) { \
                f32x4 acc = up4(LDS4(lb2 + 2 * SMB + cp * 32)); \
                _Pragma("unroll") for (int cc2 = 0; cc2 < 4; ++cc2) acc = MFMA16(LDS4(lb1 + cp * 2304 + cc2 * 32), Sb[cc2], acc); \
                Sn[cp] = pk4(acc); memclob(); } \
            _Pragma("unroll") for (int cc2 = 0; cc2 < 4; ++cc2) Sb[cc2] = Sn[cc2]; \
        } else if ((cc) >= 1) { SB_POST((cc) - 1); } \
        LBAR(); } while (0)
#define SB_POST(pcn) do { const LAS float* Yx = YX0 + ((pcn) & 1) * 4352; const LAS unsigned char* sm_ = SMALL0 + ((pcn) & 1) * 16640; \
            float y[16], s = 0.f; \
            _Pragma("unroll") for (int j4 = 0; j4 < 4; ++j4) { const f32x4 t4 = *(const LAS f32x4*)(Yx + ptt * 68 + pc + 4 * j4); y[4 * j4] = t4[0]; y[4 * j4 + 1] = t4[1]; y[4 * j4 + 2] = t4[2]; y[4 * j4 + 3] = t4[3]; } \
            _Pragma("unroll") for (int j = 0; j < 16; ++j) s += y[j]; \
            s += dppf<0xB1>(s); s += dppf<0x4E>(s); \
            const float mean = s * (1.0f / 64.0f); float s2 = 0.f; \
            _Pragma("unroll") for (int j = 0; j < 16; ++j) { y[j] -= mean; s2 += y[j] * y[j]; } \
            s2 += dppf<0xB1>(s2); s2 += dppf<0x4E>(s2); \
            const float rstd = rsqrtf(s2 * (1.0f / 64.0f) + LNX_EPS), bon = ((const LAS float*)(sm_ + 16384))[ptt]; \
            float vv[16], og[16]; \
            unpack8(*(const LAS u32x4*)(sm_ + ptt * 128 + pc * 2), *(float(*)[8])&vv[0]); unpack8(*(const LAS u32x4*)(sm_ + ptt * 128 + pc * 2 + 16), *(float(*)[8])&vv[8]); \
            unpack8(*(const LAS u32x4*)(sm_ + 8192 + ptt * 128 + pc * 2), *(float(*)[8])&og[0]); unpack8(*(const LAS u32x4*)(sm_ + 8192 + ptt * 128 + pc * 2 + 16), *(float(*)[8])&og[8]); \
            _Pragma("unroll") for (int j = 0; j < 16; ++j) y[j] = (y[j] * rstd * LGB[pc + j] + LGB[64 + pc + j] + bon * vv[j]) * og[j]; \
            const size_t tok = (size_t)(b * TT + (pcn) * 64 + ptt); \
            *(GAS u32x4*)(p1 + tok * LD1 + hc + pc) = pack8(*(float(*)[8])&y[0]); *(GAS u32x4*)(p1 + tok * LD1 + hc + pc + 8) = pack8(*(float(*)[8])&y[8]); } while (0)
        for (int c = 0; c < TT / 64; c += 2) {
            SB_ITER(c, sa, ba);
            SB_ITER(c + 1, sb, bbv);
        }
        if (!loader) SB_POST(TT / 64 - 1);
        LBAR();
    }
#undef SB_POST
#undef SB_ITER
#undef SB_STAGE
#undef SB_ISSUE
}
__device__ __forceinline__ void phase_conv(const Ctx& C, int l) {
    const bf16_t* U = WSP(bf16_t, WS_STR + ST_U); bf16_t* CB = WSP(bf16_t, WS_STR + ST_CB); const float* cw = CIN(19) + l * 3072;
    const int gt = C.bid * 512 + C.tid, NGT = C.G * 512;
    for (int i = gt; i < NT * 128; i += NGT) {
        const int t = i >> 7, c0 = (i & 127) * 8, tl = t & (TT - 1);
        float u0[8], u1[8], u2[8], cb[8], o[8];
        unpack8(*(const u32x4*)(U + (size_t)t * 1024 + c0), u0);
        if (tl >= 1) unpack8(*(const u32x4*)(U + (size_t)(t - 1) * 1024 + c0), u1); else {
#pragma unroll
            for (int j = 0; j < 8; ++j) u1[j] = 0.f; }
        if (tl >= 2) unpack8(*(const u32x4*)(U + (size_t)(t - 2) * 1024 + c0), u2); else {
#pragma unroll
            for (int j = 0; j < 8; ++j) u2[j] = 0.f; }
        u32x4* p = (u32x4*)(CB + (size_t)t * 1024 + c0); unpack8(*p, cb);
#pragma unroll
        for (int j = 0; j < 8; ++j) o[j] = cb[j] * (cw[c0 + j] * u2[j] + cw[1024 + c0 + j] * u1[j] + cw[2048 + c0 + j] * u0[j]);
        *p = pack8(o);
    }
}
__device__ __forceinline__ void phase_router(const Ctx& C, int l, LAS unsigned char* lds) {
    LAS int* cnt = (LAS int*)(lds + 126976);
    LAS float* RG = (LAS float*)lds;
    const float* g = CIN(29) + l * 1024; const float* rg = CIN(30) + (size_t)l * 1024 * 4; const float* rgb = CIN(31) + l * 4; const float* re = CIN(32) + (size_t)l * 1024 * 16; const float* reb = CIN(33) + l * 16;
    __syncthreads();
    if (C.tid < 16) cnt[C.tid] = 0;
    for (int i = C.tid; i < 1024 * 5; i += 512) { const int k = i / 5, q = i % 5; const float gk = g[k];
        const f32x4 v = (q == 0) ? *(const f32x4*)(rg + (size_t)k * 4) : *(const f32x4*)(re + (size_t)k * 16 + (q - 1) * 4);
        RG[(4 * q + 0) * 1024 + k] = v[0] * gk; RG[(4 * q + 1) * 1024 + k] = v[1] * gk; RG[(4 * q + 2) * 1024 + k] = v[2] * gk; RG[(4 * q + 3) * 1024 + k] = v[3] * gk; }
    __syncthreads();
    const int lane = C.lane, per = (NT + C.G - 1) / C.G, t0 = C.bid * per, t1 = (t0 + per) < NT ? (t0 + per) : NT;
    float* SF = WSP(float, WS_SMALL + SM_SF); int* TE = WSP(int, WS_SMALL + SM_TOKE); float* TW = WSP(float, WS_SMALL + SM_TOKW);
    for (int t = t0 + C.wave; t < t1; t += 8) {
        const GAS u32x2* xr = (const GAS u32x2*)(WSP(bf16_t, WS_XB) + (size_t)t * 1024) + lane;
        f32x4 xv[4];
#pragma unroll
        for (int jj = 0; jj < 4; ++jj) { const u32x2 w_ = xr[64 * jj]; xv[jj] = (f32x4){bflo(w_.x), bfhi(w_.x), bflo(w_.y), bfhi(w_.y)}; }
        float lg[20]; float ss = 0.f;
#pragma unroll
        for (int j = 0; j < 20; ++j) lg[j] = 0.f;
#pragma unroll
        for (int jj = 0; jj < 4; ++jj) { const f32x4 x = xv[jj]; const int k0 = (lane + 64 * jj) * 4;
            ss += x[0] * x[0] + x[1] * x[1] + x[2] * x[2] + x[3] * x[3];
#pragma unroll
            for (int j = 0; j < 20; ++j) { const f32x4 a = *(const LAS f32x4*)(RG + j * 1024 + k0); lg[j] += x[0] * a[0] + x[1] * a[1] + x[2] * a[2] + x[3] * a[3]; } }
        ss = wave_sum(ss); const float s = rsqrtf(ss * (1.0f / 1024.0f) + RMS_EPS);
#pragma unroll
        for (int j = 0; j < 20; ++j) lg[j] = wave_sum(lg[j]);
        if (lane == 0) {
            float gl[4]; int gi = 0;
#pragma unroll
            for (int j = 0; j < 4; ++j) { gl[j] = lg[j] * s + rgb[j]; }
#pragma unroll
            for (int j = 1; j < 4; ++j) if (gl[j] > gl[gi]) gi = j;
            float den = 0.f;
#pragma unroll
            for (int j = 0; j < 4; ++j) den += __expf(gl[j] - gl[gi]);
            const float gw_ = 1.0f / den;
            float el[4];
#pragma unroll
            for (int j = 0; j < 4; ++j) { float v = 0.f;
#pragma unroll
                for (int q = 0; q < 4; ++q) v = (gi == q) ? (lg[4 + q * 4 + j] * s + reb[q * 4 + j]) : v;
                el[j] = v; }
            int e1 = 0;
#pragma unroll
            for (int j = 1; j < 4; ++j) if (el[j] > el[e1]) e1 = j;
            int e2 = (e1 == 0) ? 1 : 0;
#pragma unroll
            for (int j = 0; j < 4; ++j) if (j != e1 && el[j] > el[e2]) e2 = j;
            const float p2 = __expf(el[e2] - el[e1]);
            const float w1 = gw_ / (1.0f + p2), w2 = gw_ * p2 / (1.0f + p2);
            SF[t] = s; TE[2 * t] = gi * 4 + e1; TE[2 * t + 1] = gi * 4 + e2; TW[2 * t] = w1; TW[2 * t + 1] = w2;
            atomicAdd((int*)&cnt[gi * 4 + e1], 1); atomicAdd((int*)&cnt[gi * 4 + e2], 1);
        }
    }
    __syncthreads();
    if (C.tid < 16) WSP(int, WS_SMALL + SM_BC)[C.bid * 16 + C.tid] = cnt[C.tid];
    __syncthreads();
}
__device__ __forceinline__ void phase_gather(const Ctx& C, LAS unsigned char* lds) {
    LAS int* segbase = (LAS int*)(lds + 126976); LAS int* mybase = segbase + 16; LAS int* rank = mybase + 16; LAS int* tot = rank + 16;
    const int* BC = WSP(int, WS_SMALL + SM_BC);
    __syncthreads();
    if (C.tid < 64) { mybase[C.tid & 15] = 0; tot[C.tid & 15] = 0; rank[C.tid & 15] = 0; }
    __syncthreads();
    {
        int cb[16], ct[16];
#pragma unroll
        for (int e = 0; e < 16; ++e) { cb[e] = 0; ct[e] = 0; }
        for (int b = C.tid; b < C.G; b += 512) { const int4* p = (const int4*)(BC + b * 16);
#pragma unroll
            for (int q = 0; q < 4; ++q) { const int4 v = p[q]; const int vv[4] = {v.x, v.y, v.z, v.w};
#pragma unroll
                for (int j = 0; j < 4; ++j) { ct[q * 4 + j] += vv[j]; if (b < C.bid) cb[q * 4 + j] += vv[j]; } } }
#pragma unroll
        for (int e = 0; e < 16; ++e) {
#pragma unroll
            for (int o = 1; o < 64; o <<= 1) { ct[e] += __shfl_xor(ct[e], o); cb[e] += __shfl_xor(cb[e], o); }
            if (C.lane == 0 && ct[e] != 0) { atomicAdd((int*)&tot[e], ct[e]); atomicAdd((int*)&mybase[e], cb[e]); } }
    }
    __syncthreads();
    if (C.tid == 0) { int pb = 0; int* info = WSP(int, WS_SMALL + SM_MOEINFO);
        for (int e = 0; e < 16; ++e) { segbase[e] = pb * 256; if (C.bid == 0) { info[e] = pb; info[32 + e] = pb * 4; } pb += (tot[e] + 255) >> 8; }
        if (C.bid == 0) { info[16] = pb; info[32 + 16] = pb * 4; } }
    __syncthreads();
    const int lane = C.lane, per = (NT + C.G - 1) / C.G, t0 = C.bid * per, t1 = (t0 + per) < NT ? (t0 + per) : NT;
    const int* TE = WSP(int, WS_SMALL + SM_TOKE); const float* TW = WSP(float, WS_SMALL + SM_TOKW); const float* SF = WSP(float, WS_SMALL + SM_SF);
    int* TP = WSP(int, WS_SMALL + SM_TOKPOS); float* RS = WSP(float, WS_SMALL + SM_ROWS); float* RW = WSP(float, WS_SMALL + SM_ROWW);
    int* RT = WSP(int, WS_SMALL + SM_ROWTOK);
    if (C.bid == 0) {
        for (int e = 0; e < 16; ++e) { const int p0 = segbase[e] + tot[e], p1 = segbase[e] + ((tot[e] + 255) & ~255); for (int p = p0 + C.tid; p < p1; p += 512) RT[p] = 0; } }
    for (int t = t0 + C.wave; t < t1; t += 8) {
        if (lane < 2) { const int j = lane; const int e = TE[2 * t + j];
            const int pos = segbase[e] + mybase[e] + atomicAdd((int*)&rank[e], 1);
            RT[pos] = t; TP[2 * t + j] = pos; RS[pos] = SF[t]; RW[pos] = TW[2 * t + j]; }
    }
}
__device__ __forceinline__ void phase_combine(const Ctx& C, int l) {
    const int gw = C.bid * 8 + C.wave, NGW = C.G * 8, lane = C.lane;
    const int* TP = WSP(int, WS_SMALL + SM_TOKPOS); const bf16_t* yp = WSP(bf16_t, WS_XP); float* ssa = WSP(float, WS_SMALL + SM_SSA); bf16_t* xb = WSP(bf16_t, WS_XB);
    for (int t = gw; t < NT; t += NGW) {
        const int p1 = TP[2 * t], p2 = TP[2 * t + 1];
        const GAS u32x2* xi = (const GAS u32x2*)(xb + (size_t)t * 1024) + lane; const GAS u32x2* y1 = (const GAS u32x2*)(yp + (size_t)p1 * 1024) + lane; const GAS u32x2* y2 = (const GAS u32x2*)(yp + (size_t)p2 * 1024) + lane;
        u32x2 xw[4], aw[4], bw[4];
#pragma unroll
        for (int j = 0; j < 4; ++j) { xw[j] = xi[64 * j]; aw[j] = y1[64 * j]; bw[j] = y2[64 * j]; }
        f32x4 v[4]; float s = 0.f;
#pragma unroll
        for (int j = 0; j < 4; ++j) { f32x4 x = (f32x4){bflo(xw[j].x), bfhi(xw[j].x), bflo(xw[j].y), bfhi(xw[j].y)};
            x[0] += bflo(aw[j].x) + bflo(bw[j].x); x[1] += bfhi(aw[j].x) + bfhi(bw[j].x); x[2] += bflo(aw[j].y) + bflo(bw[j].y); x[3] += bfhi(aw[j].y) + bfhi(bw[j].y);
            if (l == 0) { const u32x2 pw = (u32x2){cvt_pk_bf16(x[0], x[1]), cvt_pk_bf16(x[2], x[3])}; xw[j] = pw; x = (f32x4){bflo(pw.x), bfhi(pw.x), bflo(pw.y), bfhi(pw.y)}; }
            v[j] = x; s += x[0] * x[0] + x[1] * x[1] + x[2] * x[2] + x[3] * x[3]; }
        s = wave_sum(s);
        if (l == 1) { const float r = rsqrtf(s * (1.0f / 1024.0f) + RMS_EPS); const f32x4* g = (const f32x4*)CIN(37) + lane; GAS f32x4* o = (GAS f32x4*)(C.out + (size_t)t * 1024) + lane;
#pragma unroll
            for (int j = 0; j < 4; ++j) { const f32x4 gg = g[64 * j]; o[64 * j] = (f32x4){v[j][0] * r * gg[0], v[j][1] * r * gg[1], v[j][2] * r * gg[2], v[j][3] * r * gg[3]}; }
        } else { GAS u32x2* b = (GAS u32x2*)(xb + (size_t)t * 1024) + lane;
#pragma unroll
            for (int j = 0; j < 4; ++j) b[64 * j] = xw[j];
            if (lane == 0) ssa[t] = s; }
    }
}

template <int KIND, int MODE, int K, int lda, int ldb, bool GATHER = false>
__device__ __forceinline__ void run_gemm(const Ctx& C, LAS unsigned char* lds, int l, const char* A, const char* B, int nM, int nN, bool want_ss, const float* e0 = nullptr, const float* e1 = nullptr, const float* e2 = nullptr, const float* e3 = nullptr) {
    Sched<KIND> S; S.G = C.G; S.c = C.bid; S.layer = l; S.ws = C.ws; S.A = A; S.B = B; S.nM = nM; S.nN = nN; S.lda = lda; S.ldb = ldb;
    Epi<MODE> E; E.xlds = lds + RING_BYTES; E.layer = l; E.ep[0] = e0; E.ep[1] = e1; E.ep[2] = e2; E.ep[3] = e3; E.out = C.out; E.ws = C.ws; E.want_ss = want_ss;
    pg8::gemm_phase<K, lda, ldb, Epi<MODE>, Sched<KIND>, GATHER>(lds, C.tid, S, E, GATHER ? (const int*)(C.ws + WS_SMALL + SM_ROWTOK) : nullptr);
}
__global__ void __launch_bounds__(512, 2) fwd_kernel(Args args) {
    extern __shared__ __attribute__((aligned(16))) unsigned char lds_raw[];
    LAS unsigned char* lds = (LAS unsigned char*)lds_raw;
    Ctx C0;
    C0.out = args.out; C0.ws = args.ws; C0.G = gridDim.x; C0.bid = blockIdx.x; C0.tid = threadIdx.x; C0.lane = C0.tid & 63; C0.wave = __builtin_amdgcn_readfirstlane(C0.tid >> 6);
    volatile LAS unsigned* MISC = (volatile LAS unsigned*)(lds + MISC_OFF);
    for (int u = C0.tid; u < (LDS_BYTES - LDSCTL_OFF) / 4; u += 512) ((LAS unsigned*)(lds + LDSCTL_OFF))[u] = 0u;
    __syncthreads();
    XcdBarrier bar; bar.bar = (unsigned*)(C0.ws + WS_CTL) + CW_BAR; bar.x = 0; bar.st = nullptr;
#if MK_ONE_LAUNCH
    bar = xcd_barrier_post((unsigned*)(C0.ws + WS_CTL) + CW_BAR, MISC + 8);
#define GRID_BAR() xcd_barrier(bar)
#else
#define GRID_BAR() do { } while (0)
#endif
    const int lo = args.ph_lo, hi = args.ph_hi;
#ifndef PHMASK
#define PHMASK 0xFFFFFFFu
#endif
#define PH_EN(k) (((PHMASK) >> (k)) & 1u)
#define IN(p) (lo <= (p) && (p) < hi)
#define SEAM(p) do { if ((p) + 1 < hi) GRID_BAR(); } while (0)
#define FRESH() Ctx P = C0; int z_ = 0; { unsigned char* w_ = P.ws; float* o_ = P.out; int wv_ = P.wave, b_ = P.bid, g_ = P.G; asm volatile("" : "+s"(w_), "+s"(o_), "+s"(z_), "+s"(wv_), "+s"(b_), "+s"(g_)); P.bid = b_; P.G = g_; int t_ = wv_ * 64 + (int)__builtin_amdgcn_mbcnt_hi(~0u, __builtin_amdgcn_mbcnt_lo(~0u, 0u)); P.ws = w_; P.out = o_; P.tid = t_; P.lane = t_ & 63; P.wave = __builtin_amdgcn_readfirstlane(t_ >> 6); } const Ctx& C = P; const char* wgt = (const char*)(C.ws + WS_WGT); (void)wgt
#define LD(k) P.in[k] = args.in[(k) + z_]
#define AIN(k) (args.in[(k) + z_])
    if (PH_EN(20) && IN(0)) { FRESH(); LD(0); LD(1); LD(25); LD(27); LD(2); LD(3); LD(5); LD(8); LD(10); LD(11); LD(13); LD(21); LD(22); LD(23); LD(24); LD(26); LD(28); phase_prologue(C, lds); SEAM(0); }
#define LAYER_BODY(l) { const int pb = 1 + (l) * NPH_L; \
        if (PH_EN(0) && IN(pb + 0)) { FRESH(); run_gemm<GK_S11, EM_P1, 1024, 1024, 1024>(C, lds, l, nullptr, nullptr, 0, 0, false); SEAM(pb + 0); } \
        if (PH_EN(1) && IN(pb + 1)) { FRESH(); LD(4); LD(6); LD(14); phase_prescan(C, l); SEAM(pb + 1); } \
        if (PH_EN(2) && IN(pb + 2)) { FRESH(); run_gemm<GK_X, EM_X, 256, LD1, 256>(C, lds, l, nullptr, nullptr, 0, 0, false, AIN(7), AIN(9), AIN(12), AIN(15)); SEAM(pb + 2); } \
        if (PH_EN(3) && IN(pb + 3)) { FRESH(); LD(4); LD(14); LD(15); LD(16); phase_scanA(C, l, lds); SEAM(pb + 3); } \
        if (PH_EN(4) && IN(pb + 4)) { FRESH(); LD(17); LD(18); phase_scanB(C, l, lds); SEAM(pb + 4); } \
        if (PH_EN(5) && IN(pb + 5)) { FRESH(); run_gemm<GK_S15, EM_S15, 1024, 1024, 1024>(C, lds, l, nullptr, nullptr, 0, 0, false, AIN(20)); SEAM(pb + 5); } \
        if (PH_EN(6) && IN(pb + 6)) { FRESH(); LD(19); phase_conv(C, l); SEAM(pb + 6); } \
        if (PH_EN(7) && IN(pb + 7)) { { FRESH(); run_gemm<GK_DENSE, EM_M1, 1024, 1024, 1024>(C, lds, l, (const char*)(C.ws + WS_STR + ST_CB), wgt + WG_WBB, 64, 4, false); } \
            asm volatile("s_waitcnt vmcnt(0)" ::: "memory"); __builtin_amdgcn_fence(__ATOMIC_RELEASE, "workgroup"); __syncthreads(); __builtin_amdgcn_fence(__ATOMIC_ACQUIRE, "workgroup"); \
            { FRESH(); run_gemm<GK_DENSE, EM_MG, 1024, LD1, 1024>(C, lds, l, (const char*)(C.ws + WS_P1), wgt + WG_WBA, 64, 4, false); } SEAM(pb + 7); } \
        if (PH_EN(9) && IN(pb + 9)) { FRESH(); run_gemm<GK_DENSE, EM_RES, 1024, 1024, 1024>(C, lds, l, (const char*)(C.ws + WS_STR + ST_GA), wgt + WG_WMO, 64, 4, true, (l) == 0 ? AIN(0) : nullptr); SEAM(pb + 9); } \
        if (PH_EN(11) && IN(pb + 11)) { { FRESH(); run_gemm<GK_ATTQ, EM_Q, 1024, 1024, 1024>(C, lds, l, (const char*)(C.ws + WS_XB), wgt + WG_WQ, 64, 4, false); } \
            asm volatile("s_waitcnt vmcnt(0)" ::: "memory"); __builtin_amdgcn_fence(__ATOMIC_RELEASE, "workgroup"); __syncthreads(); __builtin_amdgcn_fence(__ATOMIC_ACQUIRE, "workgroup"); \
            { FRESH(); run_gemm<GK_ATTS, EM_ATTS, 256, 1024, 1024>(C, lds, l, nullptr, nullptr, 0, 0, false); } \
            asm volatile("s_waitcnt vmcnt(0)" ::: "memory"); __builtin_amdgcn_fence(__ATOMIC_RELEASE, "workgroup"); __syncthreads(); __builtin_amdgcn_fence(__ATOMIC_ACQUIRE, "workgroup"); \
            { FRESH(); run_gemm<GK_ATTO, EM_ATTO, 256, 1024, 2048>(C, lds, l, nullptr, nullptr, 0, 0, false); } SEAM(pb + 11); } \
        if (PH_EN(14) && IN(pb + 14)) { FRESH(); run_gemm<GK_DENSE, EM_RES, 1024, 1024, 1024>(C, lds, l, (const char*)(C.ws + WS_P1 + 32 * MiB), wgt + WG_WO, 64, 4, false); SEAM(pb + 14); } \
        if (PH_EN(15) && IN(pb + 15)) { FRESH(); LD(29); LD(30); LD(31); LD(32); LD(33); LD(34); LD(35); LD(36); LD(2); LD(3); LD(5); LD(8); LD(10); LD(11); LD(13); LD(21); LD(22); LD(23); LD(24); LD(26); LD(28); phase_router(C, l, lds); conv_expert_weights(C, l, lds); if (l == 0) conv_layer_weights(C, 1, lds); SEAM(pb + 15); } \
        if (PH_EN(16) && IN(pb + 16)) { FRESH(); phase_gather(C, lds); SEAM(pb + 16); } \
        if (PH_EN(17) && IN(pb + 17)) { FRESH(); run_gemm<GK_MOE1, EM_MOE1, 1024, 1024, 1024, true>(C, lds, l, nullptr, nullptr, 0, 0, false); SEAM(pb + 17); } \
        if (PH_EN(18) && IN(pb + 18)) { FRESH(); run_gemm<GK_MOE2, EM_MOE2, 512, 512, 512>(C, lds, l, nullptr, nullptr, 0, 0, false); SEAM(pb + 18); } \
        if (PH_EN(19) && IN(pb + 19)) { FRESH(); LD(37); phase_combine(C, l); SEAM(pb + 19); } \
    }
    LAYER_BODY(0)
    LAYER_BODY(1)
#undef IN
#undef SEAM
}

extern "C" void kernel_launch(void* const* d_in, const int* in_sizes, int n_in, void* d_out, int out_size, void* d_ws, size_t ws_size, hipStream_t stream) {
    static int grid = 0;
    if (grid == 0) {
        if (n_in != 38 || out_size != NT * DM || ws_size < WS_END) { fprintf(stderr, "kernel_launch: unexpected problem (n_in %d out %d ws %zu, need %zu)\n", n_in, out_size, ws_size, (size_t)WS_END); grid = -1; return; }
        int dev = 0, cus = 0, per_cu = 0;
        if (hipGetDevice(&dev) != hipSuccess || hipDeviceGetAttribute(&cus, hipDeviceAttributeMultiprocessorCount, dev) != hipSuccess) { grid = -1; return; }
        if (hipFuncSetAttribute((const void*)fwd_kernel, hipFuncAttributeMaxDynamicSharedMemorySize, LDS_BYTES) != hipSuccess) { grid = -1; return; }
        if (hipOccupancyMaxActiveBlocksPerMultiprocessor(&per_cu, (const void*)fwd_kernel, 512, LDS_BYTES) != hipSuccess || per_cu < 1) fprintf(stderr, "kernel_launch: occupancy query reports %d\n", per_cu);
        (void)hipGetLastError();
        grid = cus;
    }
    if (grid < 0) return;
    (void)hipMemsetAsync((char*)d_ws + WS_CTL, 0, CTL_ZERO_BYTES, stream);
    Args a{};
    for (int i = 0; i < 38; ++i) a.in[i] = (const float*)d_in[i];
    a.out = (float*)d_out; a.ws = (unsigned char*)d_ws;
#if MK_ONE_LAUNCH
    a.ph_lo = 0; a.ph_hi = NPH;
    hipLaunchKernelGGL(fwd_kernel, dim3(grid), dim3(512), LDS_BYTES, stream, a);
#else
    for (int ph = 0; ph < NPH; ++ph) { a.ph_lo = ph; a.ph_hi = ph + 1; hipLaunchKernelGGL(fwd_kernel, dim3(grid), dim3(512), LDS_BYTES, stream, a); }
#endif
}
```

```cpp
#include <hip/hip_runtime.h>
#include <cstdio>
#include <cstdint>

#ifndef MK_ONE_LAUNCH
#define MK_ONE_LAUNCH 1
#endif

#define LAS __attribute__((address_space(3)))
#define GAS __attribute__((address_space(1)))
typedef unsigned short bf16_t;
typedef short bf16x8 __attribute__((ext_vector_type(8)));
typedef float f32x4 __attribute__((ext_vector_type(4)));
typedef float f32x2 __attribute__((ext_vector_type(2)));
typedef unsigned u32x4 __attribute__((ext_vector_type(4)));
typedef unsigned u32x2 __attribute__((ext_vector_type(2)));

constexpr int NT = 16384, DM = 1024, TT = 2048, NBATCH = 8, NHEAD = 16;
constexpr int LD1 = 3584;
constexpr int INC = 8480;
constexpr int NPH_L = 20, NPH = 1 + 2 * NPH_L;
constexpr float RMS_EPS = 1e-6f, LNX_EPS = 64e-5f;

constexpr size_t MiB = 1u << 20;
constexpr size_t WS_CTL = 0, CTL_ZERO_BYTES = 1 * MiB;
constexpr size_t WS_SMALL = 1 * MiB;
constexpr size_t WS_WGT = 3 * MiB;
constexpr size_t WS_SSBP = 36 * MiB;
constexpr size_t WS_KVB = 38 * MiB;
constexpr size_t WS_XB = 54 * MiB;
constexpr size_t WS_VF = 86 * MiB;
constexpr size_t WS_P1 = 118 * MiB;
constexpr size_t WS_HALO = 230 * MiB;
constexpr size_t WS_STR = 231 * MiB;
constexpr size_t WS_END = 359 * MiB;
constexpr size_t WG_W1A = 0, WG_W1B = 7 * MiB, WG_WX1 = 17 * MiB, WG_WX2 = WG_WX1 + 3 * MiB / 2, WG_WBA = 19 * MiB, WG_WBB = 21 * MiB, WG_WMO = 23 * MiB, WG_WQ = 25 * MiB, WG_WO = 27 * MiB;
constexpr size_t ST_KK = 0, ST_WE = 32 * MiB, ST_AA = 64 * MiB, ST_OG = 96 * MiB;
constexpr size_t ST_U = 0, ST_CB = 32 * MiB, ST_GA = 64 * MiB, ST_GB = 96 * MiB;
constexpr size_t ST_PS = 0, ST_PB = 64 * MiB;
constexpr size_t ST_MN = 0, ST_WKVT = 8 * MiB;
constexpr size_t WS_XP = 118 * MiB, WS_H = 190 * MiB, WS_WE1 = 226 * MiB, WS_WE2 = 258 * MiB;
constexpr int XP_ROWS = 36864;
constexpr size_t SM_SSA = 0, SM_SF = 64 * 1024, SM_TOKE = 128 * 1024, SM_TOKW = 256 * 1024, SM_TOKPOS = 384 * 1024, SM_ROWS = 512 * 1024, SM_ROWW = 672 * 1024,
                 SM_RINV = 832 * 1024, SM_BC = 1088 * 1024, SM_MOEINFO = 1104 * 1024, SM_ROWTOK = 1120 * 1024;
constexpr int CW_BAR = 4096, CW_GC = 16384;
constexpr size_t WS_ELIST = 300 * MiB, WS_ERS = 301 * MiB, WS_ERW = 302 * MiB;
constexpr int LDS_MOEINFO = 140288;
constexpr size_t CT_SSB = 64 * 1024;

constexpr int RING_BYTES = 131072, LDS_BYTES = 147456, LDSCTL_OFF = LDS_BYTES - 512, MISC_OFF = LDSCTL_OFF + 320;

typedef __bf16 bf16v2_t __attribute__((ext_vector_type(2)));
__device__ __forceinline__ unsigned cvt_pk_bf16(float lo, float hi) { const f32x2 v = {lo, hi}; const bf16v2_t r = __builtin_convertvector(v, bf16v2_t); return __builtin_bit_cast(unsigned, r); }
__device__ __forceinline__ float bflo(unsigned w) { return __uint_as_float(w << 16); }
__device__ __forceinline__ float bfhi(unsigned w) { return __uint_as_float(w & 0xffff0000u); }
__device__ __forceinline__ float sigm(float x) { return __builtin_amdgcn_rcpf(1.0f + __expf(-x)); }
__device__ __forceinline__ void unpack8(const u32x4 w, float (&f)[8]) { f[0] = bflo(w.x); f[1] = bfhi(w.x); f[2] = bflo(w.y); f[3] = bfhi(w.y); f[4] = bflo(w.z); f[5] = bfhi(w.z); f[6] = bflo(w.w); f[7] = bfhi(w.w); }
__device__ __forceinline__ u32x4 pack8(const float (&f)[8]) { u32x4 w; w.x = cvt_pk_bf16(f[0], f[1]); w.y = cvt_pk_bf16(f[2], f[3]); w.z = cvt_pk_bf16(f[4], f[5]); w.w = cvt_pk_bf16(f[6], f[7]); return w; }
template <int CTRL> __device__ __forceinline__ float dppf(float x) { return __int_as_float(__builtin_amdgcn_update_dpp(0, __float_as_int(x), CTRL, 0xf, 0xf, false)); }
__device__ __forceinline__ float sum8(float x) { x += dppf<0xB1>(x); x += dppf<0x4E>(x); x += dppf<0x141>(x); return x; }
__device__ __forceinline__ float sum16(float x) { x = sum8(x); x += dppf<0x140>(x); return x; }
__device__ __forceinline__ float wave_sum(float v) {
    v = sum16(v);
    v += __int_as_float(__builtin_amdgcn_update_dpp(0, __float_as_int(v), 0x142, 0xa, 0xf, false));
    v += __int_as_float(__builtin_amdgcn_update_dpp(0, __float_as_int(v), 0x143, 0xc, 0xf, false));
    return __int_as_float(__builtin_amdgcn_readlane(__float_as_int(v), 63));
}
__device__ __forceinline__ float wave_max(float v) {
    v = fmaxf(v, dppf<0xB1>(v)); v = fmaxf(v, dppf<0x4E>(v)); v = fmaxf(v, dppf<0x141>(v)); v = fmaxf(v, dppf<0x140>(v));
    const float b = __int_as_float(__builtin_amdgcn_readlane(__float_as_int(v), 16)), c = __int_as_float(__builtin_amdgcn_readlane(__float_as_int(v), 32));
    return fmaxf(fmaxf(__int_as_float(__builtin_amdgcn_readlane(__float_as_int(v), 0)), b), fmaxf(c, __int_as_float(__builtin_amdgcn_readlane(__float_as_int(v), 48))));
}
__device__ __forceinline__ int fresh_lane() { int l; asm volatile("v_mbcnt_lo_u32_b32 %0, -1, 0\n\tv_mbcnt_hi_u32_b32 %0, -1, %0" : "=v"(l)); return l; }
__device__ __forceinline__ void memclob() { asm volatile("" ::: "memory"); }
#define LDS_WAIT() asm volatile("s_waitcnt lgkmcnt(0)" ::: "memory")
#define VM_WAIT() asm volatile("s_waitcnt vmcnt(0)" ::: "memory")

struct Args { const float* in[38]; float* out; unsigned char* ws; int ph_lo, ph_hi; };
struct Ctx {
    const float* in[38];
    float* out;
    unsigned char* ws;
    int G, bid, tid, lane, wave;
#ifdef GPROBE
    int skip;
#endif
};
#define CIN(i) (C.in[(i)])
#define WSP(T, off) ((T*)(C.ws + (off)))

namespace pg8 {
constexpr int BM = 256, BK = 64, HALF = 128, HTB = HALF * BK * 2, STAGE_BYTES = 8 * HTB;
__host__ __device__ __forceinline__ int lds_byte(int r, int c) { const int st = (r >> 4) * 2 + (c >> 5), rr = r & 15, cc = c & 31, ob = rr * 64 + cc * 2; return st * 1024 + (ob ^ (((ob >> 9) & 1) << 5)); }
__host__ __device__ __forceinline__ void stage_rc(int b, int& R, int& Cc) { const int st = b / 1024, sb = b % 1024, swz = sb ^ (((sb >> 9) & 1) << 5); R = (st >> 1) * 16 + swz / 64; Cc = (st & 1) * 32 + (swz % 64) / 2; }
__host__ __device__ __forceinline__ int perm32(int rho) { const int n = rho >> 4, i = rho & 15; return 8 * (i >> 2) + 4 * n + (i & 3); }
struct Unit { int pm, pn, seg, pad, nv, pad2; const char* a; const char* b; };

template <int K, int lda, int ldb, class Epi, class Sched, bool GATHER = false>
__device__ __forceinline__ void gemm_phase(LAS unsigned char* lds, const int tid, const Sched& S, const Epi& E, const int* rowtok = nullptr) {
    const int wid = __builtin_amdgcn_readfirstlane(tid >> 6), lane = tid & 63, wr = wid >> 2, wc = wid & 3, fr = lane & 15, fq = lane >> 4;
    constexpr int nt = K / BK;
    unsigned voffA[2], voffB[2];
#pragma unroll
    for (int i = 0; i < 2; ++i) { int R, Cc; stage_rc(tid * 16 + i * 8192, R, Cc); const int Rb = (R & ~31) + perm32(R & 31);
        voffA[i] = (unsigned)(R * lda + Cc) * 2u; voffB[i] = (unsigned)(Rb * ldb + Cc) * 2u; }
    const size_t kstep = (size_t)(BK * 2);
    const size_t hstepA = (size_t)HALF * lda * 2, hstepB = (size_t)HALF * ldb * 2;
    const unsigned ldsw = (unsigned)wid * 1024u;
    const int aoff = lds_byte(wr * 64 + fr, fq * 8), boff = lds_byte(wc * 32 + fr, fq * 8);
#define PG8_SA(b, h) (((b) * 2 + (h)) * HTB)
#define PG8_SB(b, h) ((4 + (b) * 2 + (h)) * HTB)
#define PG8_STAGE(bufoff, gbase, voff) do { _Pragma("unroll") for (int _i = 0; _i < 2; ++_i) \
        __builtin_amdgcn_global_load_lds((const unsigned*)((const char*)(gbase) + (voff)[_i]), (LAS unsigned*)(lds + (bufoff) + ldsw + _i * 8192), 16, 0, 0); } while (0)
#define PG8_LDA(dst, b, h) do { _Pragma("unroll") for (int m = 0; m < 4; ++m) _Pragma("unroll") for (int k = 0; k < 2; ++k) dst[m][k] = *(const LAS bf16x8*)(lds + PG8_SA(b, h) + aoff + m * 2048 + k * 1024); } while (0)
#define PG8_LDB(dst, b, h) do { _Pragma("unroll") for (int n = 0; n < 2; ++n) _Pragma("unroll") for (int k = 0; k < 2; ++k) dst[n][k] = *(const LAS bf16x8*)(lds + PG8_SB(b, h) + boff + n * 2048 + k * 1024); } while (0)
#define PG8_MMA(ai, bj, At, Bt) do { __builtin_amdgcn_s_setprio(1); _Pragma("unroll") for (int m = 0; m < 4; ++m) _Pragma("unroll") for (int n = 0; n < 2; ++n) _Pragma("unroll") for (int k = 0; k < 2; ++k) \
        acc[ai][bj][m][n] = __builtin_amdgcn_mfma_f32_16x16x32_bf16(Bt[n][k], At[m][k], acc[ai][bj][m][n], 0, 0, 0); __builtin_amdgcn_s_setprio(0); } while (0)
#define PG8_WAIT_V(n) asm volatile("s_waitcnt vmcnt(" #n ")" ::: "memory")
#define PG8_WAIT_L(n) asm volatile("s_waitcnt lgkmcnt(" #n ")" ::: "memory")
#define PG8_WAITQ() do { if constexpr (K < 512 || !Sched::multi) { PG8_WAIT_V(8); break; } const int t_ = __builtin_amdgcn_readfirstlane(t), e_ = __builtin_amdgcn_readfirstlane(eop); asm volatile("s_cmp_lg_u32 %0, 0\n\ts_cbranch_scc1 .Lwn_%=\n\ts_cmp_eq_u32 %1, 0\n\ts_cbranch_scc1 .Lwn_%=\n\ts_cmp_eq_u32 %1, 1\n\ts_cbranch_scc1 .Lwh_%=\n\ts_waitcnt vmcnt(24)\n\ts_branch .Lwe_%=\n.Lwh_%=:\n\ts_waitcnt vmcnt(16)\n\ts_branch .Lwe_%=\n.Lwn_%=:\n\ts_waitcnt vmcnt(8)\n.Lwe_%=:" :: "s"(t_), "s"(e_) : "scc", "memory"); } while (0)
#define PG8_BAR __builtin_amdgcn_s_barrier()
#define PG8_SCHED __builtin_amdgcn_sched_barrier(0)
    Unit cur, nxt; int ui = 0, eop = 0;
    if (!S.next(0, cur)) return;
    f32x4 acc[2][2][4][2];
    bf16x8 At[4][2], B0[2][2], B1[2][2];
    const char* cA = cur.a; const char* cB = cur.b;
    unsigned gA[2][2], gN[2][2], gNN[2][2];
    if constexpr (GATHER) {
#pragma unroll
        for (int h = 0; h < 2; ++h)
#pragma unroll
            for (int i = 0; i < 2; ++i) { int R, Cc; stage_rc(tid * 16 + i * 8192, R, Cc);
                Unit t1, t2; const bool h1 = S.next(1, t1), h2 = S.next(2, t2);
                const int i0 = h * 128 + R;
                const int r0 = i0 < cur.nv ? rowtok[cur.pad + i0] : 0, r1 = h1 ? (i0 < t1.nv ? rowtok[t1.pad + i0] : 0) : r0, r2 = h2 ? (i0 < t2.nv ? rowtok[t2.pad + i0] : 0) : r1;
                gA[h][i] = (unsigned)(r0 * lda + Cc) * 2u; gN[h][i] = (unsigned)(r1 * lda + Cc) * 2u; gNN[h][i] = (unsigned)(r2 * lda + Cc) * 2u; }
    }
#define PG8_STAGE_A(bufoff, gbase, half, nx) do { if constexpr (GATHER) { _Pragma("unroll") for (int _i = 0; _i < 2; ++_i) { const unsigned vo_ = (nx) ? gN[half][_i] : gA[half][_i]; \
            __builtin_amdgcn_global_load_lds((const unsigned*)((const char*)(gbase) + vo_), (LAS unsigned*)(lds + (bufoff) + ldsw + _i * 8192), 16, 0, 0); } } \
        else PG8_STAGE(bufoff, (gbase) + (half) * hstepA, voffA); } while (0)
    PG8_STAGE(PG8_SB(0, 0), cB, voffB); PG8_STAGE(PG8_SB(0, 1), cB + hstepB, voffB); PG8_STAGE_A(PG8_SA(0, 0), cA, 0, false); PG8_STAGE_A(PG8_SA(0, 1), cA, 1, false);
    if (wr == 1) PG8_BAR;
    PG8_WAIT_V(2); PG8_BAR;
    PG8_STAGE(PG8_SB(1, 0), cB + kstep, voffB); PG8_STAGE_A(PG8_SA(1, 0), cA + kstep, 0, false); PG8_STAGE(PG8_SB(1, 1), cB + hstepB + kstep, voffB);
    PG8_WAIT_V(6); PG8_BAR;
#pragma unroll
    for (int a = 0; a < 2; ++a)
#pragma unroll
        for (int b = 0; b < 2; ++b)
#pragma unroll
            for (int m = 0; m < 4; ++m)
#pragma unroll
                for (int n = 0; n < 2; ++n) acc[a][b][m][n] = (f32x4){0.f, 0.f, 0.f, 0.f};
    for (;;) {
        const bool has_next = S.next(ui + 1, nxt);
        const char* nA = has_next ? nxt.a : cA; const char* nB = has_next ? nxt.b : cB;
        for (int t = 0; t < nt; t += 2) {
            const bool last = (t == nt - 2);
            const char* a1 = cA + (size_t)(t + 1) * kstep;
            const char* a2 = last ? nA : cA + (size_t)(t + 2) * kstep; const char* b2 = last ? nB : cB + (size_t)(t + 2) * kstep;
            const char* a3 = a2 + kstep; const char* b3 = b2 + kstep;
            if (last) E.prefetch(cur, wid, lane);
            PG8_LDB(B0, 0, 0); PG8_LDB(B1, 0, 1); PG8_SCHED; PG8_LDA(At, 0, 0); PG8_STAGE_A(PG8_SA(1, 1), a1, 1, false);
            PG8_WAITQ(); PG8_WAIT_L(0); PG8_BAR; PG8_MMA(0, 0, At, B0); PG8_MMA(0, 1, At, B1); PG8_BAR; PG8_SCHED;
            PG8_LDA(At, 0, 1); PG8_STAGE(PG8_SB(0, 0), b2, voffB); PG8_STAGE(PG8_SB(0, 1), b2 + hstepB, voffB); PG8_STAGE_A(PG8_SA(0, 0), a2, 0, last && has_next);
            PG8_WAITQ(); PG8_WAIT_L(0); PG8_BAR; PG8_MMA(1, 0, At, B0); PG8_MMA(1, 1, At, B1); PG8_BAR; PG8_SCHED;
            PG8_LDB(B0, 1, 0); PG8_LDB(B1, 1, 1); PG8_SCHED; PG8_LDA(At, 1, 0); PG8_STAGE_A(PG8_SA(0, 1), a2, 1, last && has_next);
            PG8_WAIT_V(8); PG8_WAIT_L(0); PG8_BAR; PG8_MMA(0, 0, At, B0); PG8_MMA(0, 1, At, B1); PG8_BAR; PG8_SCHED;
            PG8_LDA(At, 1, 1); PG8_STAGE(PG8_SB(1, 0), b3, voffB); PG8_STAGE(PG8_SB(1, 1), b3 + hstepB, voffB); PG8_STAGE_A(PG8_SA(1, 0), a3, 0, last && has_next);
            PG8_WAIT_V(8); PG8_WAIT_L(0); PG8_BAR; PG8_MMA(1, 0, At, B0); PG8_MMA(1, 1, At, B1); PG8_BAR; PG8_SCHED;
        }
        if (wr == 0) PG8_BAR;
#ifdef GPROBE
        if (E.skip != 1)
#endif
        E(acc, cur, wr, wc, fr, fq);
        if (!has_next) break;
        if constexpr (K >= 512 && Sched::multi) eop = __builtin_amdgcn_readfirstlane(E.eops(cur) >> 3);
#pragma unroll
        for (int a = 0; a < 2; ++a)
#pragma unroll
            for (int b = 0; b < 2; ++b)
#pragma unroll
                for (int m = 0; m < 4; ++m)
#pragma unroll
                    for (int n = 0; n < 2; ++n) acc[a][b][m][n] = (f32x4){0.f, 0.f, 0.f, 0.f};
        cur = nxt; cA = nA; cB = nB; ++ui;
        if constexpr (GATHER) {
#pragma unroll
            for (int h = 0; h < 2; ++h)
#pragma unroll
                for (int i = 0; i < 2; ++i) { gA[h][i] = gN[h][i]; gN[h][i] = gNN[h][i]; } }
        if (wr == 1) PG8_BAR;
    }
    PG8_WAIT_V(0);
    PG8_BAR;
#undef PG8_SA
#undef PG8_SB
#undef PG8_STAGE
#undef PG8_STAGE_A
#undef PG8_LDA
#undef PG8_LDB
#undef PG8_MMA
#undef PG8_WAIT_V
#undef PG8_WAIT_L
#undef PG8_WAITQ
#undef PG8_BAR
#undef PG8_SCHED
}
}

#define XB_TMO      128
#define XB_XCNT(j)  (256  + 64 * (j))
#define XB_XSUB(j)  (1280 + 64 * (j))
#define XB_XGEN(j)  (2304 + 64 * (j))
#define XB_TOP      3328
#define XB_TOPGEN   3392
#define XCD_BAR_WORDS 3456
#define XB_SPIN_CAP (1u << 18)
__device__ __forceinline__ unsigned xb_ld(unsigned* p)              { return __hip_atomic_load(p, __ATOMIC_RELAXED, __HIP_MEMORY_SCOPE_AGENT); }
__device__ __forceinline__ unsigned xb_add(unsigned* p, unsigned v) { return __hip_atomic_fetch_add(p, v, __ATOMIC_RELAXED, __HIP_MEMORY_SCOPE_AGENT); }
__device__ __forceinline__ unsigned xb_xcc_id() { return (unsigned)__builtin_amdgcn_s_getreg((3 << 11) | 20) & 0xFu; }
#define XB_SPIN(cond, bar) do { unsigned _sp = 0; while (cond) { __builtin_amdgcn_s_sleep(1); \
    if ((++_sp & 255u) == 0u) { if (xb_ld(&(bar)[XB_TMO])) break; if (_sp > XB_SPIN_CAP) { atomicAdd(&(bar)[XB_TMO], 1u); break; } } } } while (0)
struct XcdBarrier { unsigned* bar; unsigned x; volatile LAS unsigned* st; };
__device__ __forceinline__ XcdBarrier xcd_barrier_post(unsigned* bar, volatile LAS unsigned* st) {
    XcdBarrier b; b.bar = bar; b.x = xb_xcc_id(); b.st = st;
    if (threadIdx.x == 0) (void)xb_add(&bar[XB_XCNT(b.x)], 1u);
    return b;
}
__device__ __forceinline__ void xcd_barrier_complete(unsigned* bar, unsigned x, unsigned& nloc, unsigned& nx) {
    const unsigned G = gridDim.x * gridDim.y * gridDim.z;
    unsigned sum, cnt, mine, sp = 0u;
    for (;;) {
        sum = 0u; cnt = 0u; mine = 0u;
#pragma unroll
        for (unsigned j = 0; j < 16; ++j) { const unsigned c = xb_ld(&bar[XB_XCNT(j)]); sum += c; cnt += (c > 0u) ? 1u : 0u; mine = (j == x) ? c : mine; }
        if (sum == G) break;
        __builtin_amdgcn_s_sleep(1);
        if ((++sp & 255u) == 0u) { if (xb_ld(&bar[XB_TMO])) break; if (sp > XB_SPIN_CAP) { atomicAdd(&bar[XB_TMO], 1u); break; } }
    }
    nloc = mine > 0u ? mine : 1u; nx = cnt > 0u ? cnt : 1u;
}
__device__ __forceinline__ void xcd_barrier(const XcdBarrier& b) {
    asm volatile("s_waitcnt vmcnt(0)" ::: "memory");
    __syncthreads();
    if (threadIdx.x == 0) {
        unsigned* bar = b.bar;
        __builtin_amdgcn_s_waitcnt(0);
        unsigned nloc = b.st[0], nx = b.st[1];
        if (nloc == 0u) { xcd_barrier_complete(bar, b.x, nloc, nx); b.st[0] = nloc; b.st[1] = nx; }
        const unsigned old = xb_add(&bar[XB_XSUB(b.x)], 1u);
        const unsigned gen = old / nloc;
        if (old + 1u == (gen + 1u) * nloc) {
            __builtin_amdgcn_fence(__ATOMIC_RELEASE, "agent");
            asm volatile("s_waitcnt vmcnt(0)" ::: "memory");
            const unsigned og = xb_add(&bar[XB_TOP], 1u);
            const unsigned tg = og / nx;
            if (og + 1u == (tg + 1u) * nx) xb_add(&bar[XB_TOPGEN], 1u);
            else XB_SPIN(xb_ld(&bar[XB_TOPGEN]) == tg, bar);
            xb_add(&bar[XB_XGEN(b.x)], 1u);
            __builtin_amdgcn_fence(__ATOMIC_ACQUIRE, "agent");
            asm volatile("s_waitcnt vmcnt(0)" ::: "memory");
        } else {
            XB_SPIN(xb_ld(&bar[XB_XGEN(b.x)]) == gen, bar);
            __builtin_amdgcn_fence(__ATOMIC_ACQUIRE, "agent");
            asm volatile("s_waitcnt vmcnt(0)" ::: "memory");
        }
    }
    __syncthreads();
}

enum GemmKind { GK_S11 = 0, GK_X, GK_S15, GK_DENSE, GK_ATTS, GK_ATTO, GK_MOE1, GK_MOE2, GK_ATTQ };
enum EpiMode { EM_P1 = 0, EM_X, EM_S15, EM_M1, EM_MG, EM_RES, EM_Q, EM_ATTS, EM_ATTO, EM_MOE1, EM_MOE2 };

__device__ __forceinline__ void dense_unit(int L, int nM, int nN, int& pm, int& pn) {
    const int nwg = nM * nN; int wgid = L;
    { const int q = nwg / 8, r = nwg % 8, xcd = wgid % 8, off = wgid / 8; wgid = (xcd < r ? xcd * (q + 1) : r * (q + 1) + (xcd - r) * q) + off; }
    const int nig = 8 * nN, gid = wgid / nig, fm = gid * 8, gsz = (nM - fm) < 8 ? (nM - fm) : 8;
    pm = fm + ((wgid % nig) % gsz); pn = (wgid % nig) / gsz;
}

template <int kind> struct Sched {
    static constexpr bool multi = (kind == GK_S11 || kind == GK_X || kind == GK_S15 || kind == GK_MOE1 || kind == GK_MOE2);
    int G, c, layer;
    const char* A; const char* B;
    int nM, nN, lda, ldb;
    const unsigned char* ws; const LAS int* linfo;
    __device__ __forceinline__ bool next(int i, pg8::Unit& u) const {
        const int L = i * G + c;
        u.seg = 0; u.pad = 0; u.nv = 0; u.pad2 = 0;
        if constexpr (kind == GK_S11) {
            const int n0 = 64 * 14;
            if (L < n0) { dense_unit(L, 64, 14, u.pm, u.pn); u.a = (const char*)(ws + WS_XB) + (size_t)u.pm * 256 * 2048; u.b = (const char*)(ws + WS_WGT + WG_W1A) + (size_t)u.pn * 256 * 2048; return true; }
            if (layer != 0) return false;
            const int r = L - n0; if (r >= 128) return false;
            const int sg = r >> 5, idx = r & 31, l2 = sg >> 1;
            const char* mn = (const char*)(ws + WS_STR + ST_MN) + (size_t)l2 * 4 * MiB;
            const char* wk = (const char*)(ws + WS_STR + ST_WKVT) + (size_t)l2 * 4 * MiB;
            u.seg = 1 + sg;
            if ((sg & 1) == 0) { u.pm = idx >> 2; u.pn = idx & 3; u.a = mn + (size_t)u.pm * 256 * 2048; u.b = wk + (size_t)u.pn * 256 * 2048; }
            else { u.pm = idx >> 3; u.pn = idx & 7; u.a = wk + (size_t)(1024 + u.pm * 256) * 2048; u.b = mn + (size_t)u.pn * 256 * 2048; }
            return true; }
        else if constexpr (kind == GK_X) {
            const int nN1 = layer ? 12 : 8, n0 = 64 * nN1;
            const char* p1 = (const char*)(ws + WS_P1);
            if (L < n0) { dense_unit(L, 64, nN1, u.pm, u.pn); u.a = p1 + (size_t)u.pm * 256 * LD1 * 2 + 3072 * 2; u.b = (const char*)(ws + WS_WGT + WG_WX1) + (size_t)u.pn * 256 * 512; return true; }
            const int r = L - n0; if (r >= 256) return false;
            u.seg = 1; dense_unit(r, 64, 4, u.pm, u.pn); u.a = p1 + (size_t)u.pm * 256 * LD1 * 2 + 3328 * 2; u.b = (const char*)(ws + WS_WGT + WG_WX2) + (size_t)u.pn * 256 * 512; return true; }
        else if constexpr (kind == GK_S15) {
            if (L >= 64 * 20) return false;
            dense_unit(L, 64, 20, u.pm, u.pn); u.a = (const char*)(ws + WS_XB) + (size_t)u.pm * 256 * 2048; u.b = (const char*)(ws + WS_WGT + WG_W1B) + (size_t)u.pn * 256 * 2048; return true; }
        else if constexpr (kind == GK_DENSE) {
            if (L >= nM * nN) return false;
            dense_unit(L, nM, nN, u.pm, u.pn); u.a = A + (size_t)u.pm * 256 * lda * 2; u.b = B + (size_t)u.pn * 256 * ldb * 2; return true; }
        else if constexpr (kind == GK_ATTQ) {
            if (L >= 256) return false;
            const int b = L >> 5, h = (L >> 3) & 3, qp = L & 7;
            u.pm = b * 8 + qp; u.pn = h;
            u.a = A + (size_t)u.pm * 256 * lda * 2; u.b = B + (size_t)u.pn * 256 * ldb * 2; return true; }
        else if constexpr (kind == GK_ATTS || kind == GK_ATTO) {
            if (L >= 256) return false;
            const int b = L >> 5, h = (L >> 3) & 3, qp = L & 7;
            u.pm = b * 8 + qp; u.pn = h;
            const char* kvb = (const char*)(ws + WS_KVB) + (size_t)layer * 8 * MiB;
            if (kind == GK_ATTS) { u.a = (const char*)(ws + WS_P1) + ((size_t)u.pm * 256 * 1024 + h * 256) * 2; u.b = kvb + ((size_t)b * 256 * 1024 + h * 256) * 2; }
            else { u.a = (const char*)(ws + WS_STR + ST_PB) + ((size_t)u.pm * 256 * 1024 + h * 256) * 2; u.b = kvb + 4 * MiB + ((size_t)h * 256 * 2048 + b * 256) * 2; }
            return true; }
        else {
            const LAS int* info = linfo;
            if (L >= info[32 + 16]) return false;
            int e = 0;
#pragma unroll 1
            for (int j = 1; j < 16; ++j) if (L >= info[32 + j]) e = j;
            const int loc = L - info[32 + e];
            u.pm = info[e] + (loc >> 2); u.pn = loc & 3; u.seg = e; u.pad = e * 16384 + (loc >> 2) * 256; u.nv = info[64 + e] - (loc >> 2) * 256;
            if (kind == GK_MOE1) { u.a = (const char*)(ws + WS_XB); u.b = (const char*)(ws + WS_WE1) + ((size_t)e * 1024 + u.pn * 256) * 2048; }
            else { u.a = (const char*)(ws + WS_H) + (size_t)u.pm * 256 * 1024; u.b = (const char*)(ws + WS_WE2) + ((size_t)e * 1024 + u.pn * 256) * 1024; }
            return true; }
    }
};

#if defined(SC1_EPI)
#define NTST(p, v) do { const u32x4 v_ = (v); asm volatile("global_store_dwordx4 %0, %1, off sc1\n\ts_nop 1" :: "v"(p), "v"(v_) : "memory"); } while (0)
#elif defined(NT_EPI)
#define NTST(p, v) __builtin_nontemporal_store((v), (p))
#else
#define NTST(p, v) (*(p) = (v))
#endif
#define PLST(p, v) (*(p) = (v))
#ifdef SC1_SA
#define ST8SC(p, v) do { const bf16x4 v_ = (v); asm volatile("global_store_dwordx2 %0, %1, off sc1" :: "v"(p), "v"(v_) : "memory"); } while (0)
#else
#define ST8SC(p, v) (*(p) = (v))
#endif
#ifdef GPROBE
#define S15ST(p, v) do { const u32x4 v_ = (v); if (skip != 2) NTST(p, v_); else asm volatile("" :: "v"(v_)); } while (0)
#else
#define S15ST(p, v) NTST(p, v)
#endif
template <int mode> struct Epi {
    int layer;
    const float* ep[4];
    float* out; unsigned char* ws;
    bool want_ss;
#ifdef GPROBE
    int skip;
#endif
    LAS unsigned char* xlds;
    static constexpr bool has_prefetch = (mode == EM_P1 || mode == EM_S15 || mode == EM_MOE2);
    __device__ __forceinline__ void prefetch(const pg8::Unit& u, int wid, int lane) const {
        if constexpr (has_prefetch) {
            const float* src = (mode == EM_MOE2) ? (const float*)(ws + WS_ERW) : (const float*)(ws + WS_SMALL + SM_SSA);
            const int row = (mode == EM_MOE2 ? u.pad : u.pm * 256) + (wid >> 2) * 64 + lane;
            LAS unsigned char* slot = xlds + wid * 1024;
            __builtin_amdgcn_global_load_lds((const unsigned*)(src + row), (LAS unsigned*)slot, 4, 0, 0);
            __builtin_amdgcn_global_load_lds((const unsigned*)(src + row + 128), (LAS unsigned*)(slot + 256), 4, 0, 0);
            if constexpr (mode == EM_S15) {
                const int typ = u.pn < 8 ? 0 : (u.pn - 8) >> 2, cb0 = u.pn < 8 ? 0 : ((u.pn - 8) & 3) * 256;
                const float* gb = ep[0] + layer * 2048 + (typ == 2 ? 1024 : 0);
                __builtin_amdgcn_global_load_lds((const unsigned*)(gb + cb0 + (lane >> 5) * 128 + (wid & 3) * 32 + (lane & 31)), (LAS unsigned*)(slot + 512), 4, 0, 0);
            }
        }
    }
    __device__ __forceinline__ int eops(const pg8::Unit& u) const {
#ifdef GPROBE
        return 0;
#else
        if constexpr (mode == EM_P1 || mode == EM_X || mode == EM_MOE2) return 16;
        else if constexpr (mode == EM_S15) return u.pn < 8 ? 8 : 16;
        else if constexpr (mode == EM_MOE1) return 8;
        else return 0;
#endif
    }
    __device__ __forceinline__ void operator()(const f32x4 (&acc)[2][2][4][2], const pg8::Unit& u, int wr, int wc, int fr_, int fq_) const {
        const int ln_ = fresh_lane(), fr = ln_ & 15, fq = ln_ >> 4;
        const int rbase = u.pm * 256 + wr * 64 + fr;
        const int cl = wc * 32 + 8 * fq;
        const int l = layer;
        const LAS float* SLOT = (const LAS float*)(xlds + (wr * 4 + wc) * 1024);
#define ROWS_LOOP _Pragma("unroll") for (int ai = 0; ai < 2; ++ai) _Pragma("unroll") for (int m = 0; m < 4; (memclob(), ++m))
#define ROW_OF(ai, m) (rbase + (ai) * 128 + (m) * 16)
#define ACC8(bj) const f32x4 v0 = acc[ai][bj][m][0], v1 = acc[ai][bj][m][1]; float v[8] = {v0[0], v0[1], v0[2], v0[3], v1[0], v1[1], v1[2], v1[3]};
#define LOAD8F(dst, p) { const f32x4 t0_ = *(const GAS f32x4*)(p), t1_ = *(const GAS f32x4*)((p) + 4); dst[0] = t0_[0]; dst[1] = t0_[1]; dst[2] = t0_[2]; dst[3] = t0_[3]; dst[4] = t1_[0]; dst[5] = t1_[1]; dst[6] = t1_[2]; dst[7] = t1_[3]; }
        if constexpr (mode == EM_P1) {
            bf16_t* dst; int ld; bool sc = false, halo = false;
            if (u.seg == 0) { dst = (bf16_t*)(ws + WS_P1); ld = LD1; sc = true; halo = true; }
            else { const int sg = u.seg - 1, l2 = sg >> 1; bf16_t* kvb = (bf16_t*)(ws + WS_KVB + (size_t)l2 * 8 * MiB); if ((sg & 1) == 0) { dst = kvb; ld = 1024; } else { dst = kvb + 2 * 1024 * 1024; ld = 2048; } }
            float sv[8];
#pragma unroll
            for (int r8 = 0; r8 < 8; ++r8) sv[r8] = SLOT[(r8 >> 2) * 64 + (r8 & 3) * 16 + fr];
#pragma unroll
            for (int r8 = 0; r8 < 8; ++r8) sv[r8] = sc ? rsqrtf(sv[r8] * (1.0f / 1024.0f) + RMS_EPS) : 1.0f;
            ROWS_LOOP { const int row = ROW_OF(ai, m); const float s = sv[ai * 4 + m];
#pragma unroll
                for (int bj = 0; bj < 2; ++bj) { ACC8(bj)
#pragma unroll
                    for (int j = 0; j < 8; ++j) v[j] *= s;
                    const int col = u.pn * 256 + bj * 128 + cl; const u32x4 w = pack8(v);
                    NTST((GAS u32x4*)(dst + (size_t)row * ld + col), w);
                    if (halo && (row & 255) == 255) NTST((GAS u32x4*)((bf16_t*)(ws + WS_HALO) + (size_t)u.pm * LD1 + col), w);
                    if (halo && (row & 63) == 63 && col < 2048) NTST((GAS u32x4*)((bf16_t*)(ws + 34 * MiB) + (size_t)(row >> 6) * 2048 + col), w); } }
        }
        else if constexpr (mode == EM_X) {
            bf16_t* p1 = (bf16_t*)(ws + WS_P1);
            if (u.seg == 1) { bf16_t* og = (bf16_t*)(ws + WS_STR + ST_OG);
                ROWS_LOOP { const int row = ROW_OF(ai, m);
#pragma unroll
                    for (int bj = 0; bj < 2; ++bj) { ACC8(bj) NTST((GAS u32x4*)(og + (size_t)row * 1024 + u.pn * 256 + bj * 128 + cl), pack8(v)); } }
            } else {
                const int typ = u.pn >> 2, cb0 = (u.pn & 3) * 256;
                const float* bias = typ == 0 ? ep[0] + l * 1024 : (typ == 1 ? ep[1] + l * 1024 : ep[2]);
                const float* ka = ep[3] + l * 1024;
                bf16_t* we = (bf16_t*)(ws + WS_STR + ST_WE); bf16_t* aa = (bf16_t*)(ws + WS_STR + ST_AA); const bf16_t* vf = (const bf16_t*)(ws + WS_VF);
#pragma unroll
                for (int bj = 0; bj < 2; ++bj) { const int c0 = cb0 + bj * 128 + cl;
#pragma unroll
                    for (int ai = 0; ai < 2; ++ai)
#pragma unroll
                        for (int mh = 0; mh < 2; ++mh) {
                            float bb[8]; LOAD8F(bb, bias + c0)
                            if (typ == 0) {
#pragma unroll
                                for (int m2 = 0; m2 < 2; ++m2) { const int m = 2 * mh + m2; const int row = ROW_OF(ai, m); ACC8(bj)
#pragma unroll
                                    for (int j = 0; j < 8; ++j) v[j] = 0.60653065971f * sigm(v[j] + bb[j]);
                                    NTST((GAS u32x4*)(we + (size_t)row * 1024 + c0), pack8(v)); }
                            } else if (typ == 1) {
#pragma unroll
                                for (int m2 = 0; m2 < 2; ++m2) { const int m = 2 * mh + m2; const int row = ROW_OF(ai, m); ACC8(bj)
#pragma unroll
                                    for (int j = 0; j < 8; ++j) v[j] = sigm(v[j] + bb[j]);
                                    NTST((GAS u32x4*)(aa + (size_t)row * 1024 + c0), pack8(v)); }
                            } else {
                                u32x4 vr[2], fr4[2];
#pragma unroll
                                for (int m2 = 0; m2 < 2; ++m2) { vr[m2] = *(const GAS u32x4*)(p1 + (size_t)ROW_OF(ai, 2 * mh + m2) * LD1 + 2048 + c0); fr4[m2] = *(const GAS u32x4*)(vf + (size_t)ROW_OF(ai, 2 * mh + m2) * 1024 + c0); }
#pragma unroll
                                for (int m2 = 0; m2 < 2; ++m2) { const int m = 2 * mh + m2; const int row = ROW_OF(ai, m); ACC8(bj) float vv[8], vff[8]; unpack8(vr[m2], vv); unpack8(fr4[m2], vff);
#pragma unroll
                                    for (int j = 0; j < 8; ++j) vv[j] = vv[j] + (vff[j] - vv[j]) * sigm(v[j] + bb[j]);
                                    NTST((GAS u32x4*)(p1 + (size_t)row * LD1 + 2048 + c0), pack8(vv)); }
                            }
                            memclob();
                        }
                }
            }
        }
        else if constexpr (mode == EM_S15) {
            float sv[8];
#pragma unroll
            for (int r8 = 0; r8 < 8; ++r8) sv[r8] = SLOT[(r8 >> 2) * 64 + (r8 & 3) * 16 + fr];
#pragma unroll
            for (int r8 = 0; r8 < 8; ++r8) sv[r8] = rsqrtf(sv[r8] * (1.0f / 1024.0f) + RMS_EPS);
            if (u.pn < 8) { bf16_t* U = (bf16_t*)(ws + WS_STR + ST_U);
                ROWS_LOOP { const int row = ROW_OF(ai, m); const float s = sv[ai * 4 + m], s2 = s * s;
                    const f32x4 x0 = acc[ai][0][m][0], x1 = acc[ai][0][m][1], c0 = acc[ai][1][m][0], c1 = acc[ai][1][m][1];
                    float v[8] = {x0[0] * c0[0] * s2, x0[1] * c0[1] * s2, x0[2] * c0[2] * s2, x0[3] * c0[3] * s2, x1[0] * c1[0] * s2, x1[1] * c1[1] * s2, x1[2] * c1[2] * s2, x1[3] * c1[3] * s2};
                    S15ST((GAS u32x4*)(U + (size_t)row * 1024 + u.pn * 128 + cl), pack8(v)); }
            } else {
                const int typ = (u.pn - 8) >> 2, cb0 = ((u.pn - 8) & 3) * 256;
                bf16_t* dst = (bf16_t*)(ws + WS_STR + (typ == 0 ? ST_CB : (typ == 1 ? ST_GA : ST_GB)));
#pragma unroll
                for (int bj = 0; bj < 2; ++bj) { const int c0 = cb0 + bj * 128 + cl;
                    float bb[8] = {0, 0, 0, 0, 0, 0, 0, 0};
                    if (typ != 0) { const f32x4 t0_ = *(const LAS f32x4*)(SLOT + 128 + bj * 32 + 8 * fq), t1_ = *(const LAS f32x4*)(SLOT + 128 + bj * 32 + 8 * fq + 4);
                        bb[0] = t0_[0]; bb[1] = t0_[1]; bb[2] = t0_[2]; bb[3] = t0_[3]; bb[4] = t1_[0]; bb[5] = t1_[1]; bb[6] = t1_[2]; bb[7] = t1_[3]; }
                    ROWS_LOOP { const int row = ROW_OF(ai, m); const float s = sv[ai * 4 + m]; ACC8(bj)
#pragma unroll
                        for (int j = 0; j < 8; ++j) { v[j] *= s; if (typ != 0) v[j] = sigm(v[j] + bb[j]); }
                        S15ST((GAS u32x4*)(dst + (size_t)row * 1024 + c0), pack8(v)); } }
            }
        }
        else if constexpr (mode == EM_M1) { bf16_t* gbp = (bf16_t*)(ws + WS_STR + ST_GB);
#pragma unroll
            for (int ai = 0; ai < 2; ++ai) { u32x4 gr[4][2];
#pragma unroll
                for (int m = 0; m < 4; ++m)
#pragma unroll
                    for (int bj = 0; bj < 2; ++bj) gr[m][bj] = *(const GAS u32x4*)(gbp + (size_t)ROW_OF(ai, m) * 1024 + u.pn * 256 + bj * 128 + cl);
#pragma unroll
                for (int m = 0; m < 4; ++m)
#pragma unroll
                    for (int bj = 0; bj < 2; ++bj) { ACC8(bj) float g[8]; unpack8(gr[m][bj], g);
#pragma unroll
                        for (int j = 0; j < 8; ++j) v[j] *= g[j];
                        PLST((GAS u32x4*)(gbp + (size_t)ROW_OF(ai, m) * 1024 + u.pn * 256 + bj * 128 + cl), pack8(v)); }
                memclob(); }
        }
        else if constexpr (mode == EM_MG) { bf16_t* gap = (bf16_t*)(ws + WS_STR + ST_GA); const bf16_t* m1 = (const bf16_t*)(ws + WS_STR + ST_GB);
#pragma unroll
            for (int ai = 0; ai < 2; ++ai)
#pragma unroll
                for (int bj = 0; bj < 2; ++bj) { u32x4 gr[4], mr[4];
#pragma unroll
                    for (int m = 0; m < 4; ++m) { const size_t o = (size_t)ROW_OF(ai, m) * 1024 + u.pn * 256 + bj * 128 + cl; gr[m] = *(const GAS u32x4*)(gap + o); mr[m] = *(const GAS u32x4*)(m1 + o); }
#pragma unroll
                    for (int m = 0; m < 4; ++m) { ACC8(bj) const size_t o = (size_t)ROW_OF(ai, m) * 1024 + u.pn * 256 + bj * 128 + cl; float g[8], mm[8]; unpack8(gr[m], g); unpack8(mr[m], mm);
#pragma unroll
                        for (int j = 0; j < 8; ++j) v[j] = v[j] * g[j] + mm[j];
                        PLST((GAS u32x4*)(gap + o), pack8(v)); }
                    memclob(); }
        }
        else if constexpr (mode == EM_RES) { bf16_t* xb = (bf16_t*)(ws + WS_XB); float* ssb = (float*)(ws + WS_SSBP); const float* xsrc = ep[0];
#pragma unroll
            for (int ai = 0; ai < 2; ++ai) { float ss[4] = {0.f, 0.f, 0.f, 0.f};
#pragma unroll
                for (int bj = 0; bj < 2; ++bj) { f32x4 xa[4], xc[4]; u32x4 xr[4];
                    if (xsrc != nullptr) {
#pragma unroll
                        for (int m = 0; m < 4; ++m) { const GAS f32x4* xp = (const GAS f32x4*)(xsrc + (size_t)ROW_OF(ai, m) * 1024 + u.pn * 256 + bj * 128 + cl); xa[m] = xp[0]; xc[m] = xp[1]; }
                    } else {
#pragma unroll
                        for (int m = 0; m < 4; ++m) xr[m] = *(const GAS u32x4*)(xb + (size_t)ROW_OF(ai, m) * 1024 + u.pn * 256 + bj * 128 + cl);
#pragma unroll
                        for (int m = 0; m < 4; ++m) { float t8[8]; unpack8(xr[m], t8); xa[m] = (f32x4){t8[0], t8[1], t8[2], t8[3]}; xc[m] = (f32x4){t8[4], t8[5], t8[6], t8[7]}; }
                    }
#pragma unroll
                    for (int m = 0; m < 4; ++m) { ACC8(bj) const size_t o = (size_t)ROW_OF(ai, m) * 1024 + u.pn * 256 + bj * 128 + cl;
                        v[0] += xa[m][0]; v[1] += xa[m][1]; v[2] += xa[m][2]; v[3] += xa[m][3]; v[4] += xc[m][0]; v[5] += xc[m][1]; v[6] += xc[m][2]; v[7] += xc[m][3];
                        const u32x4 pw = pack8(v); PLST((GAS u32x4*)(xb + o), pw);
                        float r8[8]; unpack8(pw, r8);
#pragma unroll
                        for (int j = 0; j < 8; ++j) ss[m] += r8[j] * r8[j]; }
                    memclob(); }
                if (want_ss) {
#pragma unroll
                    for (int m = 0; m < 4; ++m) { float s_ = ss[m]; s_ += __shfl_xor(s_, 16); s_ += __shfl_xor(s_, 32); if (fq == 0) *(GAS float*)(ssb + (size_t)ROW_OF(ai, m) * 16 + u.pn * 4 + wc) = s_; } } }
        }
        else if constexpr (mode == EM_Q) { bf16_t* q = (bf16_t*)(ws + WS_P1); const float* ssb = (const float*)(ws + WS_SSBP);
            float sv[8];
#pragma unroll
            for (int ai = 0; ai < 2; ++ai) { f32x4 sp[4][4];
#pragma unroll
                for (int m = 0; m < 4; ++m)
#pragma unroll
                    for (int x = 0; x < 4; ++x) sp[m][x] = *((const GAS f32x4*)(ssb + (size_t)ROW_OF(ai, m) * 16) + x);
#pragma unroll
                for (int m = 0; m < 4; ++m) { const f32x4 s0 = sp[m][0], s1 = sp[m][1], s2 = sp[m][2], s3 = sp[m][3];
                    const float sst = ((s0[0] + s0[1]) + (s0[2] + s0[3])) + ((s1[0] + s1[1]) + (s1[2] + s1[3])) + (((s2[0] + s2[1]) + (s2[2] + s2[3])) + ((s3[0] + s3[1]) + (s3[2] + s3[3])));
                    sv[ai * 4 + m] = rsqrtf(sst * (1.0f / 1024.0f) + RMS_EPS); } }
            ROWS_LOOP { const int row = ROW_OF(ai, m); const float s = sv[ai * 4 + m];
#pragma unroll
                for (int bj = 0; bj < 2; ++bj) { ACC8(bj)
#pragma unroll
                    for (int j = 0; j < 8; ++j) v[j] *= s;
                    PLST((GAS u32x4*)(q + (size_t)row * 1024 + u.pn * 256 + bj * 128 + cl), pack8(v)); } }
        }
        else if constexpr (mode == EM_ATTS) {
            bf16_t* pb = (bf16_t*)(ws + WS_STR + ST_PB); float* rinv = (float*)(ws + WS_SMALL + SM_RINV);
            LAS float* XM = (LAS float*)xlds; LAS float* XS = XM + 1024;
            float mx[8];
#pragma unroll
            for (int r8 = 0; r8 < 8; ++r8) { const int ai = r8 >> 2, m = r8 & 3; float t = -3.0e38f;
#pragma unroll
                for (int bj = 0; bj < 2; ++bj) { const f32x4 a0 = acc[ai][bj][m][0], a1 = acc[ai][bj][m][1]; t = fmaxf(t, fmaxf(fmaxf(fmaxf(a0[0], a0[1]), fmaxf(a0[2], a0[3])), fmaxf(fmaxf(a1[0], a1[1]), fmaxf(a1[2], a1[3])))); }
                t = fmaxf(t, __shfl_xor(t, 16)); t = fmaxf(t, __shfl_xor(t, 32)); mx[r8] = t;
                if (fq == 0) XM[(ai * 128 + wr * 64 + m * 16 + fr) * 4 + wc] = t; }
            asm volatile("s_waitcnt lgkmcnt(0)" ::: "memory"); __builtin_amdgcn_s_barrier(); asm volatile("" ::: "memory");
            float sm[8];
#pragma unroll
            for (int r8 = 0; r8 < 8; ++r8) { const int ai = r8 >> 2, m = r8 & 3; const int rl = ai * 128 + wr * 64 + m * 16 + fr; const f32x4 q4 = *(const LAS f32x4*)(XM + rl * 4);
                const float rm = fmaxf(fmaxf(q4[0], q4[1]), fmaxf(q4[2], q4[3])); float s_ = 0.f; const int row = ROW_OF(ai, m);
#pragma unroll
                for (int bj = 0; bj < 2; ++bj) { const f32x4 a0 = acc[ai][bj][m][0], a1 = acc[ai][bj][m][1];
                    float p[8] = {__expf(a0[0] - rm), __expf(a0[1] - rm), __expf(a0[2] - rm), __expf(a0[3] - rm), __expf(a1[0] - rm), __expf(a1[1] - rm), __expf(a1[2] - rm), __expf(a1[3] - rm)};
                    const u32x4 w = pack8(p); float pr[8]; unpack8(w, pr);
#pragma unroll
                    for (int j = 0; j < 8; ++j) s_ += pr[j];
                    PLST((GAS u32x4*)(pb + ((size_t)row * 4 + u.pn) * 256 + bj * 128 + cl), w); }
                s_ += __shfl_xor(s_, 16); s_ += __shfl_xor(s_, 32); sm[r8] = s_;
                if (fq == 0) XS[rl * 4 + wc] = s_; }
            asm volatile("s_waitcnt lgkmcnt(0)" ::: "memory"); __builtin_amdgcn_s_barrier(); asm volatile("" ::: "memory");
            if (wc == 0 && fq == 0) {
#pragma unroll
                for (int r8 = 0; r8 < 8; ++r8) { const int ai = r8 >> 2, m = r8 & 3; const int rl = ai * 128 + wr * 64 + m * 16 + fr; const f32x4 q4 = *(const LAS f32x4*)(XS + rl * 4);
                    *(GAS float*)(rinv + (size_t)ROW_OF(ai, m) * 4 + u.pn) = 1.0f / ((q4[0] + q4[1]) + (q4[2] + q4[3])); } }
            (void)mx; (void)sm;
        }
        else if constexpr (mode == EM_ATTO) { bf16_t* o = (bf16_t*)(ws + WS_P1 + 32 * MiB); const float* rinv = (const float*)(ws + WS_SMALL + SM_RINV);
#pragma unroll
            for (int ai = 0; ai < 2; ++ai) { float sv[4];
#pragma unroll
                for (int m = 0; m < 4; ++m) sv[m] = *(const GAS float*)(rinv + ROW_OF(ai, m) * 4 + u.pn);
#pragma unroll
                for (int m = 0; m < 4; (memclob(), ++m)) { const int row = ROW_OF(ai, m); const float s = sv[m];
#pragma unroll
                    for (int bj = 0; bj < 2; ++bj) { ACC8(bj)
#pragma unroll
                        for (int j = 0; j < 8; ++j) v[j] *= s;
                        PLST((GAS u32x4*)(o + (size_t)row * 1024 + u.pn * 256 + bj * 128 + cl), pack8(v)); } } }
        }
        else if constexpr (mode == EM_MOE1) { bf16_t* H = (bf16_t*)(ws + WS_H); const float* rs = (const float*)(ws + WS_ERS) + u.pad + wr * 64 + fr;
            float sv[8];
#pragma unroll
            for (int r8 = 0; r8 < 8; ++r8) sv[r8] = *(const GAS float*)(rs + (r8 >> 2) * 128 + (r8 & 3) * 16);
            ROWS_LOOP { const int row = ROW_OF(ai, m); const float s = sv[ai * 4 + m];
                const f32x4 g0 = acc[ai][0][m][0], g1 = acc[ai][0][m][1], u0 = acc[ai][1][m][0], u1 = acc[ai][1][m][1];
                float g[8] = {g0[0], g0[1], g0[2], g0[3], g1[0], g1[1], g1[2], g1[3]}, uu[8] = {u0[0], u0[1], u0[2], u0[3], u1[0], u1[1], u1[2], u1[3]}, v[8];
#pragma unroll
                for (int j = 0; j < 8; ++j) { const float gg = g[j] * s; v[j] = gg * sigm(gg) * (uu[j] * s); }
                NTST((GAS u32x4*)(H + (size_t)row * 512 + u.pn * 128 + cl), pack8(v)); }
        }
        else if constexpr (mode == EM_MOE2) { bf16_t* Y = (bf16_t*)(ws + WS_XP);
            float sv[8];
#pragma unroll
            for (int r8 = 0; r8 < 8; ++r8) sv[r8] = SLOT[(r8 >> 2) * 64 + (r8 & 3) * 16 + fr];
            ROWS_LOOP { const int row = ROW_OF(ai, m); const float s = sv[ai * 4 + m];
#pragma unroll
                for (int bj = 0; bj < 2; ++bj) { ACC8(bj)
#pragma unroll
                    for (int j = 0; j < 8; ++j) v[j] *= s;
                    NTST((GAS u32x4*)(Y + (size_t)row * 1024 + u.pn * 256 + bj * 128 + cl), pack8(v)); } }
        }
#undef ROWS_LOOP
#undef ROW_OF
#undef ACC8
#undef LOAD8F
    }
};

__device__ __forceinline__ void tconv_item(const float* src, int src_ld, int col0, const float* gain, float scale, bf16_t* dst, int dst_ld, int k0, int n0, LAS float* scr, int lane) {
    const int r = lane >> 3, c4 = (lane & 7) * 4;
    f32x4 v[8];
#pragma unroll
    for (int i = 0; i < 8; ++i) v[i] = *(const f32x4*)(src + (size_t)(k0 + 8 * i + r) * src_ld + col0 + n0 + c4);
#pragma unroll
    for (int i = 0; i < 8; ++i) { const int kk = 8 * i + r; float g = scale; if (gain) g *= gain[k0 + kk];
        LAS float* d = scr + kk * 33 + c4; d[0] = v[i][0] * g; d[1] = v[i][1] * g; d[2] = v[i][2] * g; d[3] = v[i][3] * g; }
    LDS_WAIT(); asm volatile("" ::: "memory");
    const int c = lane & 7;
#pragma unroll
    for (int j = 0; j < 4; ++j) { const int n = (lane >> 3) + 8 * j; const LAS float* s = scr + (8 * c) * 33 + n;
        u32x4 o; o.x = cvt_pk_bf16(s[0 * 33], s[1 * 33]); o.y = cvt_pk_bf16(s[2 * 33], s[3 * 33]); o.z = cvt_pk_bf16(s[4 * 33], s[5 * 33]); o.w = cvt_pk_bf16(s[6 * 33], s[7 * 33]);
        *(u32x4*)(dst + (size_t)(n0 + n) * dst_ld + k0 + 8 * c) = o; }
    LDS_WAIT(); asm volatile("" ::: "memory");
}
struct Seg { const float* src; const float* gain; bf16_t* dst; int src_ld, col0, ncols, K, dst_ld; float scale; };
constexpr int NSEG_MAX = 40;
__device__ __forceinline__ void conv_layer_weights(const Ctx& C, int l, LAS unsigned char* lds, int kb_ = -2, int nb_ = 0, int part = 0) {
    if (kb_ == -2) { kb_ = C.bid; nb_ = C.G; }
    Seg* tab = (Seg*)((unsigned char*)lds + 122880); int* pre = (int*)((unsigned char*)lds + 122880 + NSEG_MAX * sizeof(Seg)); int* nsegp = pre + NSEG_MAX + 1;
    __syncthreads();
    if (C.tid == 0) {
        int n = 0; int items = 0;
        const float* W = CIN(3) + (size_t)l * 1024 * INC; const float* nm = CIN(2) + l * 1024;
        bf16_t* w1a = WSP(bf16_t, WS_WGT + WG_W1A); bf16_t* w1b = WSP(bf16_t, WS_WGT + WG_W1B);
#define ADDSEG(S_, G_, D_, LD_, C0_, NC_, K_, DLD_, SC_) do { Seg s; s.src = (S_); s.gain = (G_); s.dst = (D_); s.src_ld = (LD_); s.col0 = (C0_); s.ncols = (NC_); s.K = (K_); s.dst_ld = (DLD_); s.scale = (SC_); \
        tab[n] = s; pre[n] = items; items += ((K_) / 64) * ((NC_) / 32); ++n; } while (0)
        ADDSEG(W, nm, w1a, INC, 0, 3072, 1024, 1024, 1.f);
        ADDSEG(W, nm, w1a + 3072 * 1024, INC, 3072, 64, 1024, 1024, 1.f);
        ADDSEG(W, nm, w1a + 3136 * 1024, INC, 3136, 64, 1024, 1024, 1.f);
        ADDSEG(W, nm, w1a + 3328 * 1024, INC, 3200, 160, 1024, 1024, 1.f);
        if (l == 1) ADDSEG(CIN(5), nm, w1a + 3200 * 1024, 32, 0, 32, 1024, 1024, 1.f);
        for (int q = 0; q < 8; ++q) { ADDSEG(W, nm, w1b + (size_t)(256 * q) * 1024, INC, 3360 + 128 * q, 128, 1024, 1024, 1.f); ADDSEG(W, nm, w1b + (size_t)(256 * q + 128) * 1024, INC, 3360 + 2048 + 128 * q, 128, 1024, 1024, 1.f); }
        ADDSEG(W, nm, w1b + (size_t)2048 * 1024, INC, 3360 + 1024, 1024, 1024, 1024, 1.f);
        ADDSEG(W, nm, w1b + (size_t)3072 * 1024, INC, 6432, 1024, 1024, 1024, 1.f);
        ADDSEG(W, nm, w1b + (size_t)4096 * 1024, INC, 7456, 1024, 1024, 1024, 1.f);
        ADDSEG(CIN(21) + (size_t)l * 1048576, nullptr, WSP(bf16_t, WS_WGT + WG_WBA), 1024, 0, 1024, 1024, 1024, 1.f);
        ADDSEG(CIN(22) + (size_t)l * 1048576, nullptr, WSP(bf16_t, WS_WGT + WG_WBB), 1024, 0, 1024, 1024, 1024, 1.f);
        ADDSEG(CIN(23) + (size_t)l * 1048576, nullptr, WSP(bf16_t, WS_WGT + WG_WMO), 1024, 0, 1024, 1024, 1024, 1.f);
        ADDSEG(CIN(26) + (size_t)l * 1048576, CIN(24) + l * 1024, WSP(bf16_t, WS_WGT + WG_WQ), 1024, 0, 1024, 1024, 1024, 0.0625f);
        ADDSEG(CIN(28) + (size_t)l * 1048576, nullptr, WSP(bf16_t, WS_WGT + WG_WO), 1024, 0, 1024, 1024, 1024, 1.f);
#undef ADDSEG
        pre[n] = items; *nsegp = n;
    }
    __syncthreads();
    const int nseg = *nsegp, total = pre[nseg];
    LAS float* scr = (LAS float*)(lds + C.wave * 8704);
    const int gw = kb_ * 8 + C.wave, NGW = nb_ * 8;
    const int it_lo = (part == 2) ? total / 2 : 0, it_hi = (part == 1) ? total / 2 : total;
    if (kb_ >= 0) for (int it = it_lo + gw; it < it_hi; it += NGW) {
        int s = 0;
        for (int j = 1; j < nseg; ++j) if (it >= pre[j]) s = j;
        const Seg sg = tab[s]; const int r = it - pre[s], nblk = sg.ncols / 32, kb = r / nblk, nb = r % nblk;
        tconv_item(sg.src, sg.src_ld, sg.col0, sg.gain, sg.scale, sg.dst, sg.dst_ld, 64 * kb, 32 * nb, scr, C.lane);
    }
    if (kb_ < 0 || part == 1) return;
    const int gt = kb_ * 512 + C.tid, NGT = nb_ * 512;
    { bf16_t* w1a = WSP(bf16_t, WS_WGT + WG_W1A); const int z0 = (l == 1) ? 3232 : 3200;
        const int nz = (3328 - z0) + 96;
        for (int i = gt; i < nz * 128; i += NGT) { const int rr = i / 128, cc = i % 128; const int row = rr < (3328 - z0) ? z0 + rr : 3488 + (rr - (3328 - z0)); *(u32x4*)(w1a + (size_t)row * 1024 + cc * 8) = (u32x4){0u, 0u, 0u, 0u}; } }
    { bf16_t* wx1 = WSP(bf16_t, WS_WGT + WG_WX1); const float* du = CIN(8) + (size_t)l * 64 * 1024; const float* au = CIN(10) + (size_t)l * 64 * 1024; const float* vu = CIN(13);
        for (int i = gt; i < 3072 * 32; i += NGT) { const int kg = i / 3072, n = i - kg * 3072, typ = n >> 10, nn = n & 1023, k0 = kg * 8;
            const float* sp = nullptr;
            if (typ == 0) { if (k0 < 64) sp = du + (size_t)k0 * 1024 + nn; } else if (typ == 1) { if (k0 >= 64 && k0 < 128) sp = au + (size_t)(k0 - 64) * 1024 + nn; } else { if (l == 1 && k0 >= 128 && k0 < 160) sp = vu + (size_t)(k0 - 128) * 1024 + nn; }
            u32x4 o = (u32x4){0u, 0u, 0u, 0u};
            if (sp != nullptr) { float v[8];
#pragma unroll
                for (int j = 0; j < 8; ++j) v[j] = *(const GAS float*)(sp + j * 1024);
                o = pack8(v); }
            *(GAS u32x4*)(wx1 + (size_t)n * 256 + k0) = o; }
        bf16_t* wx2 = WSP(bf16_t, WS_WGT + WG_WX2); const float* gu = CIN(11) + (size_t)l * 160 * 1024;
        for (int i = gt; i < 1024 * 32; i += NGT) { const int kg = i >> 10, n = i & 1023, k0 = kg * 8;
            u32x4 o = (u32x4){0u, 0u, 0u, 0u};
            if (k0 < 160) { float v[8];
#pragma unroll
                for (int j = 0; j < 8; ++j) v[j] = *(const GAS float*)(gu + (size_t)(k0 + j) * 1024 + n);
                o = pack8(v); }
            *(GAS u32x4*)(wx2 + (size_t)n * 256 + k0) = o; } }
}
__device__ __forceinline__ void conv_expert_weights(const Ctx& C, int l, LAS unsigned char* lds, int which, int kb_, int nb_) {
    LAS float* scr = (LAS float*)(lds + C.wave * 8704);
    const int gw = kb_ * 8 + C.wave, NGW = nb_ * 8;
    const float* nf = CIN(29) + l * 1024;
    const int per_e = (which == 1) ? 512 : 256;
    if (kb_ >= 0) for (int it = gw; it < 16 * per_e; it += NGW) {
        const int e = it / per_e, r = (it % per_e) + (which == 1 ? 0 : 512);
        if (r < 512) { const int kb = r >> 5, nb = r & 31, n0 = 32 * nb, q = n0 >> 8, within = n0 & 255, which = within >> 7, hid = q * 128 + (within & 127);
            const float* src = (which ? CIN(35) : CIN(34)) + ((size_t)l * 16 + e) * 1024 * 512;
            tconv_item(src, 512, hid, nf, 1.f, WSP(bf16_t, WS_WE1) + ((size_t)e * 1024 + n0) * 1024, 1024, 64 * kb, 0, scr, C.lane);
        } else { const int r2 = r - 512, kb = r2 >> 5, nb = r2 & 31;
            const float* src = CIN(36) + ((size_t)l * 16 + e) * 512 * 1024;
            tconv_item(src, 1024, 0, nullptr, 1.f, WSP(bf16_t, WS_WE2) + (size_t)e * 1024 * 512, 512, 64 * kb, 32 * nb, scr, C.lane); }
    }
}
__device__ __forceinline__ void phase_prologue(const Ctx& C, LAS unsigned char* lds) {
    const int gw = C.bid * 8 + C.wave, NGW = C.G * 8, lane = C.lane;
    float* ssa = WSP(float, WS_SMALL + SM_SSA); bf16_t* xb = WSP(bf16_t, WS_XB);
    for (int m = gw; m < NT; m += NGW) {
        const f32x4* xr = (const f32x4*)(CIN(0) + (size_t)m * 1024) + lane; u32x2* b = (u32x2*)(xb + (size_t)m * 1024) + lane;
        float s = 0.f;
#pragma unroll
        for (int j = 0; j < 4; ++j) { const f32x4 v = xr[64 * j]; s += v[0] * v[0] + v[1] * v[1] + v[2] * v[2] + v[3] * v[3]; b[64 * j] = (u32x2){cvt_pk_bf16(v[0], v[1]), cvt_pk_bf16(v[2], v[3])}; }
        s = wave_sum(s); if (lane == 0) ssa[m] = s;
    }
    for (int m = gw; m < 2048; m += NGW) {
        const f32x4* xr = (const f32x4*)(CIN(1) + (size_t)m * 1024) + lane; f32x4 v[4]; float s = 0.f;
#pragma unroll
        for (int j = 0; j < 4; ++j) { v[j] = xr[64 * j]; s += v[j][0] * v[j][0] + v[j][1] * v[j][1] + v[j][2] * v[j][2] + v[j][3] * v[j][3]; }
        s = rsqrtf(wave_sum(s) * (1.0f / 1024.0f) + RMS_EPS);
#pragma unroll
        for (int l = 0; l < 2; ++l) { const f32x4* g = (const f32x4*)(CIN(25) + l * 1024) + lane; u32x2* b = (u32x2*)(WSP(bf16_t, WS_STR + ST_MN) + (size_t)l * 2048 * 1024 + (size_t)m * 1024) + lane;
#pragma unroll
            for (int j = 0; j < 4; ++j) { const f32x4 gg = g[64 * j]; b[64 * j] = (u32x2){cvt_pk_bf16(v[j][0] * s * gg[0], v[j][1] * s * gg[1]), cvt_pk_bf16(v[j][2] * s * gg[2], v[j][3] * s * gg[3])}; } }
    }
    { LAS float* scr = (LAS float*)(lds + C.wave * 8704);
        for (int it = gw; it < 2 * 16 * 64; it += NGW) { const int l = it >> 10, r = it & 1023, kb = r >> 6, nb = r & 63;
            tconv_item(CIN(27) + (size_t)l * 1024 * 2048, 2048, 0, nullptr, 1.f, WSP(bf16_t, WS_STR + ST_WKVT) + (size_t)l * 2048 * 1024, 1024, 64 * kb, 32 * nb, scr, lane); } }
    conv_layer_weights(C, 0, lds);
}
__device__ __forceinline__ void phase_prescan(const Ctx& C, int l) {
    const int lane = C.lane, rg = lane >> 3, cg = lane & 7;
    bf16_t* p1 = WSP(bf16_t, WS_P1); const bf16_t* halo = WSP(bf16_t, WS_HALO); bf16_t* VF = WSP(bf16_t, WS_VF);
    const float* mu_in = CIN(4) + l * 3360; const float* mu_v = CIN(6);
    const int gw = C.bid * 8 + C.wave, NGW = C.G * 8;
    for (int wu = gw; wu < 64 * 24; wu += NGW) {
        const int pm = wu / 24, s = 32 + (wu % 24);
        int act = 0, mui = -1; bool active = true;
        const int c8 = cg * 8;
        if (s < 48) mui = s * 64 + c8;
        else if (s == 48) { act = 1; mui = 3072 + c8; }
        else if (s == 49) { mui = 3136 + c8; }
        else if (s == 50) { if (l == 1 && cg < 4) mui = -2; else active = false; }
        else if (s == 52 || s == 53) { act = 2; mui = 3200 + (s - 52) * 64 + c8; }
        else if (s == 54) { if (cg < 4) { act = 2; mui = 3200 + 128 + c8; } else active = false; }
        else active = false;
        if (!active) continue;
        float mu[8];
        { const float* mp = (mui == -2) ? mu_v + c8 : mu_in + mui; const f32x4 a = *(const GAS f32x4*)mp, b = *(const GAS f32x4*)(mp + 4); mu[0] = a[0]; mu[1] = a[1]; mu[2] = a[2]; mu[3] = a[3]; mu[4] = b[0]; mu[5] = b[1]; mu[6] = b[2]; mu[7] = b[3]; }
        const bool isv = (s < 48);
        const int col = s * 64 + c8, r0 = pm * 256 + rg * 32;
        u32x4 praw;
        if (rg == 0) { if ((pm & 7) == 0) praw = (u32x4){0u, 0u, 0u, 0u}; else praw = *(const GAS u32x4*)(halo + (size_t)(pm - 1) * LD1 + col); }
        else praw = *(const GAS u32x4*)(p1 + (size_t)(r0 - 1) * LD1 + col);
        u32x4 raw[8];
#pragma unroll
        for (int i = 0; i < 8; ++i) raw[i] = *(const GAS u32x4*)(p1 + (size_t)(r0 + i) * LD1 + col);
        asm volatile("s_waitcnt vmcnt(0)" ::: "memory");
        float prev[8]; unpack8(praw, prev);
#pragma unroll 1
        for (int bt = 0; bt < 4; ++bt) {
            u32x4 nxt[8];
            if (bt < 3) {
#pragma unroll
                for (int i = 0; i < 8; ++i) nxt[i] = *(const GAS u32x4*)(p1 + (size_t)(r0 + 8 * (bt + 1) + i) * LD1 + col); }
#pragma unroll
            for (int i = 0; i < 8; ++i) { const int row = r0 + 8 * bt + i; float cur[8], o[8]; unpack8(raw[i], cur);
#pragma unroll
                for (int j = 0; j < 8; ++j) { float v = cur[j] + (prev[j] - cur[j]) * mu[j]; if (act == 1) v = 2.0f * sigm(2.0f * v) - 1.0f; else if (act == 2) v = sigm(v);        o[j] = v; prev[j] = cur[j]; }
                const u32x4 w = pack8(o); *(GAS u32x4*)(p1 + (size_t)row * LD1 + col) = w;
                if (isv && l == 0) *(GAS u32x4*)(VF + (size_t)row * 1024 + (s - 32) * 64 + c8) = w; }
            if (bt < 3) {
#pragma unroll
                for (int i = 0; i < 8; ++i) raw[i] = nxt[i]; }
        }
    }
}
typedef short bf16x4 __attribute__((ext_vector_type(4)));
#define MFMA16(a, b, c) __builtin_amdgcn_mfma_f32_16x16x16bf16_1k((a), (b), (c), 0, 0, 0)
#define MFMA32(a, b, c) __builtin_amdgcn_mfma_f32_16x16x32_bf16((a), (b), (c), 0, 0, 0)
__device__ __forceinline__ bf16x4 pk4(const f32x4 v) { u32x2 w; w.x = cvt_pk_bf16(v[0], v[1]); w.y = cvt_pk_bf16(v[2], v[3]); return __builtin_bit_cast(bf16x4, w); }
__device__ __forceinline__ f32x4 up4(const bf16x4 h) { const u32x2 w = __builtin_bit_cast(u32x2, h); return (f32x4){bflo(w.x), bfhi(w.x), bflo(w.y), bfhi(w.y)}; }
__device__ __forceinline__ f32x4 addI(f32x4 v, int i, int q) {
#pragma unroll
    for (int e = 0; e < 4; ++e) v[e] += (4 * q + e == i) ? 1.0f : 0.0f;
    return v; }
__device__ __forceinline__ void scat8(LAS unsigned char* mat, int row0, int col, const u32x4 p) {
    LAS bf16_t* m = (LAS bf16_t*)mat; const unsigned wv[4] = {p.x, p.y, p.z, p.w};
#pragma unroll
    for (int j = 0; j < 8; ++j) m[(row0 + j) * 72 + col] = (bf16_t)((j & 1) ? (wv[j >> 1] >> 16) : (wv[j >> 1] & 0xffffu)); }
constexpr int SMB = 64 * 144;
enum { M_At = 0, M_Rt, M_Bm, M_Km, M_AtT, M_VT, M_BtT, M_KtT, M_Aab, M_AabT, M_Aak, M_Arb, M_Ark, M_ApT = M_Bm, M_VpT = M_Km };
constexpr size_t WS_BON = 33 * MiB;
constexpr size_t WS_BND = 34 * MiB;
#define SMAT(m) (lds + (m) * SMB)
#define LDS4(p) (*(const LAS bf16x4*)(p))
#define LDS8(p) (*(const LAS bf16x8*)(p))
__device__ __forceinline__ void settle(f32x4& a) { asm volatile("s_nop 7\n\ts_nop 7" : "+v"(a)); }
__device__ __forceinline__ f32x4 tile64(const LAS unsigned char* X, const LAS unsigned char* Y, int mb, int nb, int i, int q, f32x4 acc) {
    acc = MFMA32(LDS8(Y + (16 * nb + i) * 144 + (8 * q) * 2), LDS8(X + (16 * mb + i) * 144 + (8 * q) * 2), acc);
    acc = MFMA32(LDS8(Y + (16 * nb + i) * 144 + (8 * q + 32) * 2), LDS8(X + (16 * mb + i) * 144 + (8 * q + 32) * 2), acc);
    settle(acc);
    return acc; }
#define LBAR() do { asm volatile("s_waitcnt lgkmcnt(0)" ::: "memory"); __builtin_amdgcn_s_barrier(); asm volatile("" ::: "memory"); } while (0)
__device__ __forceinline__ void phase_scanA(const Ctx& C, int l, LAS unsigned char* lds) {
    const int tid = C.tid, lane = C.lane, w = C.wave, i = lane & 15, q = lane >> 4;
    const int tt = tid >> 3, c8 = (tid & 7) * 8;
    bf16_t* p1 = WSP(bf16_t, WS_P1); bf16_t* WEp = WSP(bf16_t, WS_STR + ST_WE); bf16_t* AAp = WSP(bf16_t, WS_STR + ST_AA); bf16_t* KKp = WSP(bf16_t, WS_STR + ST_KK); float* BON = WSP(float, WS_BON);
    LAS float* LW = (LAS float*)(lds + 8 * SMB); LAS float* W63 = (LAS float*)(lds + 13 * SMB); LAS float* GT = W63 + 64; LAS float* RK = GT + 512; LAS float* CT = RK + 1024;
    const float* rkp = CIN(16) + l * 1024;
    const f32x4 z4 = (f32x4){0.f, 0.f, 0.f, 0.f};
    u32x4 in_r, in_k, in_v, in_we, in_aa, in_rp, in_kp;
    const float* mup = CIN(4) + l * 3360; const float* kkg = CIN(14) + l * 1024; const float* kag = CIN(15) + l * 1024;
    const unsigned offp = (unsigned)(tt * LD1 + c8) * 2u, offs = (unsigned)(tt * 1024 + c8) * 2u;
#define SA_LOAD(uu) do { const int bh_ = (uu) >> 5, c_ = (uu) & 31; const size_t t0_ = (size_t)((bh_ >> 4) * TT + c_ * 64); const int h0_ = (bh_ & 15) * 64; \
        const char* bp_ = (const char*)(p1 + t0_ * LD1 + h0_); const char* bw_ = (const char*)(WEp + t0_ * 1024 + h0_); const char* ba_ = (const char*)(AAp + t0_ * 1024 + h0_); \
        in_r = *(const GAS u32x4*)(bp_ + offp); in_k = *(const GAS u32x4*)(bp_ + 2048 + offp); in_v = *(const GAS u32x4*)(bp_ + 4096 + offp); \
        in_we = *(const GAS u32x4*)(bw_ + offs); in_aa = *(const GAS u32x4*)(ba_ + offs); \
        if (tt == 0) { if (c_ == 0) { in_rp = (u32x4){0u, 0u, 0u, 0u}; in_kp = in_rp; } else { const bf16_t* bq_ = WSP(bf16_t, WS_BND) + ((t0_ - 1) >> 6) * 2048 + h0_ + c8; in_rp = *(const GAS u32x4*)bq_; in_kp = *(const GAS u32x4*)(bq_ + 1024); } } \
        else { in_rp = *(const GAS u32x4*)(bp_ + offp - LD1 * 2); in_kp = *(const GAS u32x4*)(bp_ + 2048 + offp - LD1 * 2); } } while (0)
    constexpr int NU = 4096;
    for (int x = tid; x < 1024; x += 512) { RK[x] = rkp[x]; CT[x] = mup[x]; CT[1024 + x] = mup[1024 + x]; CT[2048 + x] = kkg[x]; CT[3072 + x] = kag[x]; }
    LBAR();
#ifndef SASKIP
#define SASKIP 0
#endif
#define SA_ON(k) (dost_ || !((SASKIP >> (k)) & 1))
#ifdef SAREP
    _Pragma("unroll 1") for (int rep_ = 0; rep_ < SAREP; ++rep_) { const bool dost_ = (rep_ == SAREP - 1); asm volatile("" ::: "memory");
#else
    { const bool dost_ = true;
#endif
    int u = C.bid;
    if (u < NU) SA_LOAD(u);
    asm volatile("" : "+v"(in_r), "+v"(in_k), "+v"(in_v), "+v"(in_we), "+v"(in_aa), "+v"(in_rp), "+v"(in_kp));
    for (; u < NU; u += C.G) {
        const int bh = u >> 5, c = u & 31, b = bh >> 4, h = bh & 15, tok0 = b * TT + c * 64, hc = h * 64;

        float r[8], k[8], we[8], aa[8], kk[8];
        asm volatile("" : "+v"(in_r), "+v"(in_k), "+v"(in_v), "+v"(in_we), "+v"(in_aa), "+v"(in_rp), "+v"(in_kp));
        unpack8(in_r, r); unpack8(in_k, k); unpack8(in_we, we); unpack8(in_aa, aa);
        {
            float rp[8], kp[8]; unpack8(in_rp, rp); unpack8(in_kp, kp);
            float mur[8], muk[8], kkc[8], kac[8];
#pragma unroll
            for (int hh = 0; hh < 2; ++hh) { const f32x4 c0 = *(const LAS f32x4*)(CT + hc + c8 + 4 * hh), c1 = *(const LAS f32x4*)(CT + 1024 + hc + c8 + 4 * hh), c2 = *(const LAS f32x4*)(CT + 2048 + hc + c8 + 4 * hh), c3 = *(const LAS f32x4*)(CT + 3072 + hc + c8 + 4 * hh);
#pragma unroll
                for (int j = 0; j < 4; ++j) { mur[4 * hh + j] = c0[j]; muk[4 * hh + j] = c1[j]; kkc[4 * hh + j] = c2[j]; kac[4 * hh + j] = c3[j]; } }
            float ssq = 0.f;
#pragma unroll
            for (int j = 0; j < 8; ++j) { r[j] = r[j] + (rp[j] - r[j]) * mur[j]; k[j] = k[j] + (kp[j] - k[j]) * muk[j]; kk[j] = k[j] * kkc[j]; ssq += kk[j] * kk[j]; }
            ssq = sum8(ssq);
            const float inv = __builtin_amdgcn_rsqf(fmaxf(ssq, 1e-24f));
#pragma unroll
            for (int j = 0; j < 8; ++j) { kk[j] = kk[j] * inv; k[j] = k[j] * (1.0f + (aa[j] - 1.0f) * kac[j]); }
        }
        const u32x4 vraw = in_v;
        if (u + C.G < NU) SA_LOAD(u + C.G);
        if (SA_ON(1)) {
#pragma unroll
        for (int j = 0; j < 8; ++j) LW[tt * 68 + c8 + j] = -we[j];
        LBAR();
        { const int g = tid >> 6, kx = tid & 63; float cs_[8]; float run = 0.f;
#pragma unroll
            for (int n = 0; n < 8; ++n) { run += LW[(8 * g + n) * 68 + kx]; cs_[n] = run; }
            GT[g * 64 + kx] = run;
            LBAR();
            float off = 0.f;
#pragma unroll
            for (int gg = 0; gg < 7; ++gg) off += (gg < g) ? GT[gg * 64 + kx] : 0.f;
#pragma unroll
            for (int n = 0; n < 8; ++n) LW[(8 * g + n) * 68 + kx] = cs_[n] + off; }
        LBAR();
        }
        if (SA_ON(2)) {
        {
            float at[8], rt[8], bm[8], km[8], bt[8], kt[8]; float bon = 0.f, e63[8];
            float Lv[8], Lm[8], Lev[8], rkv[8];
            { const f32x4 a0 = *(const LAS f32x4*)(LW + tt * 68 + c8), a1 = *(const LAS f32x4*)(LW + tt * 68 + c8 + 4), e0 = *(const LAS f32x4*)(LW + 63 * 68 + c8), e1 = *(const LAS f32x4*)(LW + 63 * 68 + c8 + 4);
                const f32x4 r0 = *(const LAS f32x4*)(RK + hc + c8), r1 = *(const LAS f32x4*)(RK + hc + c8 + 4);
                f32x4 m0 = (f32x4){0.f, 0.f, 0.f, 0.f}, m1 = m0; if (tt) { m0 = *(const LAS f32x4*)(LW + (tt - 1) * 68 + c8); m1 = *(const LAS f32x4*)(LW + (tt - 1) * 68 + c8 + 4); }
#pragma unroll
                for (int j = 0; j < 4; ++j) { Lv[j] = a0[j]; Lv[4 + j] = a1[j]; Lev[j] = e0[j]; Lev[4 + j] = e1[j]; Lm[j] = m0[j]; Lm[4 + j] = m1[j]; rkv[j] = r0[j]; rkv[4 + j] = r1[j]; } }
#pragma unroll
            for (int j = 0; j < 8; ++j) {
                const float L = Lv[j], Lm1 = Lm[j], Le = Lev[j];
                const float eL = __expf(L), eLm1 = __expf(Lm1), einv = __builtin_amdgcn_rcpf(eL), eend = __expf(Le) * einv, bv = kk[j] * aa[j];
                at[j] = -kk[j] * eLm1; rt[j] = r[j] * eL; bm[j] = bv * einv; km[j] = k[j] * einv; bt[j] = bv * eend; kt[j] = k[j] * eend;
                bon += r[j] * k[j] * rkv[j]; e63[j] = eL;
            }
            bon = sum8(bon);
            if ((tid & 7) == 0) *(GAS float*)(BON + (size_t)(tok0 + tt) * 16 + h) = bon;
            if (tt == 63) {
#pragma unroll
                for (int j = 0; j < 8; ++j) W63[c8 + j] = e63[j]; }
            *(LAS u32x4*)(SMAT(M_At) + tt * 144 + c8 * 2) = pack8(at); *(LAS u32x4*)(SMAT(M_Rt) + tt * 144 + c8 * 2) = pack8(rt);
            *(LAS u32x4*)(SMAT(M_Bm) + tt * 144 + c8 * 2) = pack8(bm); *(LAS u32x4*)(SMAT(M_Km) + tt * 144 + c8 * 2) = pack8(km);
            *(LAS u32x4*)(SMAT(M_Aak) + tt * 144 + c8 * 2) = vraw; *(LAS u32x4*)(SMAT(M_Arb) + tt * 144 + c8 * 2) = pack8(bt); *(LAS u32x4*)(SMAT(M_Ark) + tt * 144 + c8 * 2) = pack8(kt);
        }
        LBAR();
        }
        if (SA_ON(3)) {
        {
            const int tl = lane, ch0 = 8 * w;
            scat8(SMAT(M_AtT), ch0, tl, *(const LAS u32x4*)(SMAT(M_At) + tl * 144 + ch0 * 2)); scat8(SMAT(M_VT), ch0, tl, *(const LAS u32x4*)(SMAT(M_Aak) + tl * 144 + ch0 * 2));
            scat8(SMAT(M_BtT), ch0, tl, *(const LAS u32x4*)(SMAT(M_Arb) + tl * 144 + ch0 * 2)); scat8(SMAT(M_KtT), ch0, tl, *(const LAS u32x4*)(SMAT(M_Ark) + tl * 144 + ch0 * 2));
        }
        LBAR();
        }
        if (SA_ON(4)) {
        {
            const int tb = w & 3; const bool incl = (w >= 4);
            const LAS unsigned char* X = SMAT(incl ? M_Rt : M_At);
            const bf16x8 xf0 = LDS8(X + (16 * tb + i) * 144 + (8 * q) * 2), xf1 = LDS8(X + (16 * tb + i) * 144 + (8 * q + 32) * 2);
#pragma unroll
            for (int nt = 0; nt < 8; ++nt) {
                const int jb = nt & 3; const bool isK = nt >= 4;
                const LAS unsigned char* Y = SMAT(isK ? M_Km : M_Bm);
                LAS unsigned char* O = SMAT(incl ? (isK ? M_Ark : M_Arb) : (isK ? M_Aak : M_Aab));
                f32x4 acc = z4;
                if (jb <= tb) {
                    acc = MFMA32(LDS8(Y + (16 * jb + i) * 144 + (8 * q) * 2), xf0, acc);
                    acc = MFMA32(LDS8(Y + (16 * jb + i) * 144 + (8 * q + 32) * 2), xf1, acc);
                    settle(acc);
                    if (jb == tb) {
#pragma unroll
                        for (int e = 0; e < 4; ++e) { const int jj = 4 * q + e; const bool keep = incl ? (jj <= i) : (jj < i); acc[e] = keep ? acc[e] : 0.f; } }
                }
                const bf16x4 pk = pk4(acc);
                *(LAS bf16x4*)(O + (16 * tb + i) * 144 + (16 * jb + 4 * q) * 2) = pk;
                if (!incl && !isK && jb == tb) { const u32x2 pw = __builtin_bit_cast(u32x2, pk); LAS bf16_t* T = (LAS bf16_t*)SMAT(M_AabT);
                    T[(16 * jb + 4 * q + 0) * 72 + 16 * tb + i] = (bf16_t)(pw.x & 0xffffu); T[(16 * jb + 4 * q + 1) * 72 + 16 * tb + i] = (bf16_t)(pw.x >> 16);
                    T[(16 * jb + 4 * q + 2) * 72 + 16 * tb + i] = (bf16_t)(pw.y & 0xffffu); T[(16 * jb + 4 * q + 3) * 72 + 16 * tb + i] = (bf16_t)(pw.y >> 16); }
            }
        }
        LBAR();
        }
        if (SA_ON(5)) {
        {
            const int cs = 16 * (w & 3); const bool isA = (w < 4);
            f32x4 rhs[4];
            if (isA) {
                const int I = w;
                const bf16x4 nt_ = LDS4(SMAT(M_Aab) + (16 * I + i) * 144 + (16 * I + 4 * q) * 2);
                const bf16x4 nn_ = LDS4(SMAT(M_AabT) + (16 * I + i) * 144 + (16 * I + 4 * q) * 2);
                const bf16x4 e2n = pk4(MFMA16(nt_, nn_, z4)), e2t = pk4(MFMA16(nn_, nt_, z4));
                const bf16x4 e4n = pk4(MFMA16(e2t, e2n, z4)), e4t = pk4(MFMA16(e2n, e2t, z4));
                const f32x4 e8n = MFMA16(e4t, e4n, z4);
                const bf16x4 g2 = pk4(MFMA16(pk4(addI(up4(e4t), i, q)), pk4(addI(e8n, i, q)), z4));
                const bf16x4 g1t = pk4(MFMA16(pk4(addI(up4(e2n), i, q)), pk4(addI(up4(nt_), i, q)), z4));
                *(LAS bf16x4*)(SMAT(M_AabT) + (16 * I + i) * 144 + (16 * ((I + 1) & 3) + 4 * q) * 2) = pk4(MFMA16(g2, g1t, z4));
#pragma unroll
                for (int I2 = 0; I2 < 4; ++I2) rhs[I2] = up4(LDS4(SMAT(M_AtT) + (cs + i) * 144 + (16 * I2 + 4 * q) * 2));
            } else {
#pragma unroll
                for (int I2 = 0; I2 < 4; ++I2) { f32x4 acc = z4;
#pragma unroll
                    for (int J = 0; J <= I2; ++J) acc = MFMA16(LDS4(SMAT(M_Aak) + (16 * I2 + i) * 144 + (16 * J + 4 * q) * 2), LDS4(SMAT(M_VT) + (cs + i) * 144 + (16 * J + 4 * q) * 2), acc);
                    rhs[I2] = acc; }
            }
            LBAR();
            bf16x4 Xb[4];
            LAS unsigned char* XO = SMAT(isA ? M_ApT : M_VpT);
#pragma unroll
            for (int I = 0; I < 4; ++I) {
                f32x4 acc = rhs[I];
#pragma unroll
                for (int J = 0; J < I; ++J) acc = MFMA16(LDS4(SMAT(M_Aab) + (16 * I + i) * 144 + (16 * J + 4 * q) * 2), Xb[J], acc);
                const bf16x4 tal = LDS4(SMAT(M_AabT) + (16 * I + i) * 144 + (16 * ((I + 1) & 3) + 4 * q) * 2);
                Xb[I] = pk4(MFMA16(tal, pk4(acc), z4));
                *(LAS bf16x4*)(XO + (cs + i) * 144 + (16 * I + 4 * q) * 2) = Xb[I];
            }
        }
        LBAR();
        }
        asm volatile("" : "+v"(in_r), "+v"(in_k), "+v"(in_v), "+v"(in_we), "+v"(in_aa), "+v"(in_rp), "+v"(in_kp));
        if (SA_ON(6)) {
        {
            const int mat = w >> 1;
            const LAS unsigned char* X1 = SMAT(mat == 0 ? M_BtT : (mat == 2 ? M_Arb : M_VpT));
            const LAS unsigned char* Y1 = SMAT(mat == 0 ? M_ApT : (mat == 1 ? M_BtT : (mat == 2 ? M_ApT : M_Arb)));
            const LAS unsigned char* X2 = SMAT(M_VT);
            const LAS unsigned char* Y2 = SMAT(mat == 1 ? M_KtT : M_Ark);
            const bool two = (mat == 1) || (mat == 3);
            bf16_t* dst = mat == 0 ? KKp : (mat == 1 ? WEp : (mat == 2 ? AAp : p1 + 1024)); const int ld = (mat == 3) ? LD1 : 1024;
#pragma unroll
            for (int mm = 0; mm < 2; ++mm) { const int mb = 2 * (w & 1) + mm;
                const bf16x8 xa0 = LDS8(X1 + (16 * mb + i) * 144 + (8 * q) * 2), xa1 = LDS8(X1 + (16 * mb + i) * 144 + (8 * q + 32) * 2);
                bf16x8 xb0 = xa0, xb1 = xa1;
                if (two) { xb0 = LDS8(X2 + (16 * mb + i) * 144 + (8 * q) * 2); xb1 = LDS8(X2 + (16 * mb + i) * 144 + (8 * q + 32) * 2); }
#pragma unroll
                for (int nb = 0; nb < 4; ++nb) {
                    f32x4 acc = z4;
                    acc = MFMA32(LDS8(Y1 + (16 * nb + i) * 144 + (8 * q) * 2), xa0, acc);
                    acc = MFMA32(LDS8(Y1 + (16 * nb + i) * 144 + (8 * q + 32) * 2), xa1, acc);
                    if (two) { acc = MFMA32(LDS8(Y2 + (16 * nb + i) * 144 + (8 * q) * 2), xb0, acc); acc = MFMA32(LDS8(Y2 + (16 * nb + i) * 144 + (8 * q + 32) * 2), xb1, acc); }
                    settle(acc);
                    if (mat == 0) {
#pragma unroll
                        for (int e = 0; e < 4; ++e) acc[e] += (16 * mb + i == 16 * nb + 4 * q + e) ? W63[16 * mb + i] : 0.f; }
                    else if (mat == 2) { const f32x4 rr = up4(LDS4(SMAT(M_Rt) + (16 * mb + i) * 144 + (16 * nb + 4 * q) * 2)); acc = acc + rr; }
                    { const bf16x4 pv_ = pk4(acc); if (dost_) ST8SC((GAS bf16x4*)(dst + (size_t)(tok0 + 16 * mb + i) * ld + hc + 16 * nb + 4 * q), pv_); else asm volatile("" :: "v"(pv_)); }
                } }
        }
        LBAR();
        }
    }
    }
#undef SA_LOAD
}
__device__ __forceinline__ void phase_scanB(const Ctx& C, int l, LAS unsigned char* lds) {
    const int tid = C.tid, lane = C.lane, w = C.wave, i = lane & 15, q = lane >> 4;
    bf16_t* p1 = WSP(bf16_t, WS_P1); const bf16_t* WEp = WSP(bf16_t, WS_STR + ST_WE); const bf16_t* AAp = WSP(bf16_t, WS_STR + ST_AA); const bf16_t* KKp = WSP(bf16_t, WS_STR + ST_KK); const bf16_t* OGp = WSP(bf16_t, WS_STR + ST_OG);
    const float* BON = WSP(float, WS_BON);
    LAS unsigned char* PTm = lds; LAS unsigned char* Rh = lds + SMB; LAS unsigned char* Gm = lds + 2 * SMB; LAS unsigned char* Y0m = lds + 3 * SMB;
    LAS unsigned char* SMALL0 = lds + 4 * SMB;
    LAS float* YX0 = (LAS float*)(lds + 4 * SMB + 2 * 16640);
    const bool loader = (w < 4);
    const int lt = tid & 255;
    const int row0 = lt >> 3, c16 = (lt & 7) * 8;
    const int ptt = lt >> 2, pc = (lt & 3) * 16;
#ifdef SBREP
    _Pragma("unroll 1") for (int rep_ = 0; rep_ < SBREP; ++rep_) for (int u = C.bid; u < NBATCH * NHEAD; u += C.G) { asm volatile("" ::: "memory");
#else
    for (int u = C.bid; u < NBATCH * NHEAD; u += C.G) {
#endif
        const int b = u >> 4, h = u & 15, hc = h * 64;
        LAS float* LGB = YX0 + 2 * 4352;
        if (tid < 128) LGB[tid] = (tid < 64 ? CIN(17) : CIN(18))[l * 1024 + hc + (tid & 63)];
        u32x4 sa[12], sb[12]; float ba = 0.f, bbv = 0.f;
        const unsigned os0 = (unsigned)(row0 * 1024 + c16) * 2u, os1 = os0 + 32u * 1024u * 2u, op0 = (unsigned)(row0 * LD1 + c16) * 2u, op1 = op0 + 32u * LD1 * 2u;
#define SB_ISSUE(cc, S_, B_) do { const size_t t0_ = (size_t)(b * TT + (cc) * 64); \
            const char* bk_ = (const char*)(KKp + t0_ * 1024 + hc); const char* ba_ = (const char*)(AAp + t0_ * 1024 + hc); const char* bw_ = (const char*)(WEp + t0_ * 1024 + hc); const char* bo_ = (const char*)(OGp + t0_ * 1024 + hc); const char* bp_ = (const char*)(p1 + t0_ * LD1 + hc); \
            S_[0] = *(const GAS u32x4*)(bk_ + os0); S_[1] = *(const GAS u32x4*)(bk_ + os1); S_[2] = *(const GAS u32x4*)(ba_ + os0); S_[3] = *(const GAS u32x4*)(ba_ + os1); S_[4] = *(const GAS u32x4*)(bw_ + os0); S_[5] = *(const GAS u32x4*)(bw_ + os1); \
            S_[6] = *(const GAS u32x4*)(bp_ + 2048 + op0); S_[7] = *(const GAS u32x4*)(bp_ + 2048 + op1); S_[8] = *(const GAS u32x4*)(bp_ + 4096 + op0); S_[9] = *(const GAS u32x4*)(bp_ + 4096 + op1); S_[10] = *(const GAS u32x4*)(bo_ + os0); S_[11] = *(const GAS u32x4*)(bo_ + os1); \
            if (lt < 64) B_ = *(const GAS float*)(BON + (t0_ + lt) * 16 + h); } while (0)
#define SB_STAGE(cc, S_, B_) do { LAS unsigned char* sm_ = SMALL0 + ((cc) & 1) * 16640; _Pragma("unroll") for (int k2 = 0; k2 < 2; ++k2) { const int r_ = row0 + 32 * k2; \
            *(LAS u32x4*)(PTm + r_ * 144 + c16 * 2) = S_[0 + k2]; *(LAS u32x4*)(Rh + r_ * 144 + c16 * 2) = S_[2 + k2]; *(LAS u32x4*)(Gm + r_ * 144 + c16 * 2) = S_[4 + k2]; *(LAS u32x4*)(Y0m + r_ * 144 + c16 * 2) = S_[6 + k2]; \
            *(LAS u32x4*)(sm_ + r_ * 128 + c16 * 2) = S_[8 + k2]; *(LAS u32x4*)(sm_ + 8192 + r_ * 128 + c16 * 2) = S_[10 + k2]; } \
            if (lt < 64) ((LAS float*)(sm_ + 16384))[lt] = B_; } while (0)
        bf16x4 Sb[4];
#pragma unroll
        for (int cc = 0; cc < 4; ++cc) Sb[cc] = (bf16x4){0, 0, 0, 0};
        if (loader) { SB_ISSUE(0, sa, ba); SB_ISSUE(1, sb, bbv); }
#define SB_ITER(cc, S_, B_) do { \
        if (loader) { asm volatile("" : "+v"(S_[0]), "+v"(S_[1]), "+v"(S_[2]), "+v"(S_[3]), "+v"(S_[4]), "+v"(S_[5]), "+v"(S_[6]), "+v"(S_[7]), "+v"(S_[8]), "+v"(S_[9]), "+v"(S_[10]), "+v"(S_[11]), "+v"(B_)); \
            SB_STAGE(cc, S_, B_); if ((cc) + 2 < TT / 64) SB_ISSUE((cc) + 2, S_, B_); } \
        LBAR(); \
        if (loader) { \
            const LAS unsigned char* lb1 = lds + (i * 144 + q * 8); const LAS unsigned char* lb2 = lb1 + w * 2304; \
            LAS float* yb = YX0 + ((cc) & 1) * 4352 + (4 * q * 68 + 16 * w + i); \
            _Pragma("unroll") for (int tb = 0; tb < 4; ++tb) { \
                f32x4 acc = up4(LDS4(lb2 + 3 * SMB + tb * 32)); \
                _Pragma("unroll") for (int cc2 = 0; cc2 < 4; ++cc2) acc = MFMA16(LDS4(lb1 + SMB + tb * 2304 + cc2 * 32), Sb[cc2], acc); \
                _Pragma("unroll") for (int e = 0; e < 4; ++e) yb[(16 * tb + e) * 68] = acc[e]; memclob(); } \
            bf16x4 Sn[4]; \
            _Pragma("unroll") for (int cp = 0; cp < 4; ++cp) { \
                f32x4 acc = up4(LDS4(lb2 + 2 * SMB + cp * 32)); \
                _Pragma("unroll") for (int cc2 = 0; cc2 < 4; ++cc2) acc = MFMA16(LDS4(lb1 + cp * 2304 + cc2 * 32), Sb[cc2], acc); \
                Sn[cp] = pk4(acc); memclob(); } \
            _Pragma("unroll") for (int cc2 = 0; cc2 < 4; ++cc2) Sb[cc2] = Sn[cc2]; \
        } else if ((cc) >= 1) { SB_POST((cc) - 1); } \
        LBAR(); } while (0)
#define SB_POST(pcn) do { const LAS float* Yx = YX0 + ((pcn) & 1) * 4352; const LAS unsigned char* sm_ = SMALL0 + ((pcn) & 1) * 16640; \
            float y[16], s = 0.f; \
            _Pragma("unroll") for (int j4 = 0; j4 < 4; ++j4) { const f32x4 t4 = *(const LAS f32x4*)(Yx + ptt * 68 + pc + 4 * j4); y[4 * j4] = t4[0]; y[4 * j4 + 1] = t4[1]; y[4 * j4 + 2] = t4[2]; y[4 * j4 + 3] = t4[3]; } \
            _Pragma("unroll") for (int j = 0; j < 16; ++j) s += y[j]; \
            s += dppf<0xB1>(s); s += dppf<0x4E>(s); \
            const float mean = s * (1.0f / 64.0f); float s2 = 0.f; \
            _Pragma("unroll") for (int j = 0; j < 16; ++j) { y[j] -= mean; s2 += y[j] * y[j]; } \
            s2 += dppf<0xB1>(s2); s2 += dppf<0x4E>(s2); \
            const float rstd = rsqrtf(s2 * (1.0f / 64.0f) + LNX_EPS), bon = ((const LAS float*)(sm_ + 16384))[ptt]; \
            float vv[16], og[16]; \
            unpack8(*(const LAS u32x4*)(sm_ + ptt * 128 + pc * 2), *(float(*)[8])&vv[0]); unpack8(*(const LAS u32x4*)(sm_ + ptt * 128 + pc * 2 + 16), *(float(*)[8])&vv[8]); \
            unpack8(*(const LAS u32x4*)(sm_ + 8192 + ptt * 128 + pc * 2), *(float(*)[8])&og[0]); unpack8(*(const LAS u32x4*)(sm_ + 8192 + ptt * 128 + pc * 2 + 16), *(float(*)[8])&og[8]); \
            _Pragma("unroll") for (int j = 0; j < 16; ++j) y[j] = (y[j] * rstd * LGB[pc + j] + LGB[64 + pc + j] + bon * vv[j]) * og[j]; \
            const size_t tok = (size_t)(b * TT + (pcn) * 64 + ptt); \
            *(GAS u32x4*)(p1 + tok * LD1 + hc + pc) = pack8(*(float(*)[8])&y[0]); *(GAS u32x4*)(p1 + tok * LD1 + hc + pc + 8) = pack8(*(float(*)[8])&y[8]); } while (0)
        for (int c = 0; c < TT / 64; c += 2) {
            SB_ITER(c, sa, ba);
            SB_ITER(c + 1, sb, bbv);
        }
        if (!loader) SB_POST(TT / 64 - 1);
        LBAR();
    }
#undef SB_POST
#undef SB_ITER
#undef SB_STAGE
#undef SB_ISSUE
}
__device__ __forceinline__ void phase_conv(const Ctx& C, int l) {
    const bf16_t* U = WSP(bf16_t, WS_STR + ST_U); bf16_t* CB = WSP(bf16_t, WS_STR + ST_CB); const float* cw = CIN(19) + l * 3072;
    const int gt = C.bid * 512 + C.tid, NGT = C.G * 512;
    for (int i = gt; i < NT * 128; i += NGT) {
        const int t = i >> 7, c0 = (i & 127) * 8, tl = t & (TT - 1);
        float u0[8], u1[8], u2[8], cb[8], o[8];
        unpack8(*(const u32x4*)(U + (size_t)t * 1024 + c0), u0);
        if (tl >= 1) unpack8(*(const u32x4*)(U + (size_t)(t - 1) * 1024 + c0), u1); else {
#pragma unroll
            for (int j = 0; j < 8; ++j) u1[j] = 0.f; }
        if (tl >= 2) unpack8(*(const u32x4*)(U + (size_t)(t - 2) * 1024 + c0), u2); else {
#pragma unroll
            for (int j = 0; j < 8; ++j) u2[j] = 0.f; }
        u32x4* p = (u32x4*)(CB + (size_t)t * 1024 + c0); unpack8(*p, cb);
#pragma unroll
        for (int j = 0; j < 8; ++j) o[j] = cb[j] * (cw[c0 + j] * u2[j] + cw[1024 + c0 + j] * u1[j] + cw[2048 + c0 + j] * u0[j]);
        *p = pack8(o);
    }
}
__device__ __forceinline__ void phase_router(const Ctx& C, int l, LAS unsigned char* lds) {
    LAS int* cnt = (LAS int*)(lds + 126976); LAS int* gbase = cnt + 16; LAS int* rank = cnt + 32; LAS int* le = cnt + 48; LAS float* lw = (LAS float*)(cnt + 48 + 256); LAS float* lsf = lw + 256;
    LAS float* RG = (LAS float*)lds;
    const float* g = CIN(29) + l * 1024; const float* rg = CIN(30) + (size_t)l * 1024 * 4; const float* rgb = CIN(31) + l * 4; const float* re = CIN(32) + (size_t)l * 1024 * 16; const float* reb = CIN(33) + l * 16;
    __syncthreads();
    if (C.tid < 16) cnt[C.tid] = 0;
    for (int i = C.tid; i < 1024 * 5; i += 512) { const int k = i / 5, q = i % 5; const float gk = g[k];
        const f32x4 v = (q == 0) ? *(const f32x4*)(rg + (size_t)k * 4) : *(const f32x4*)(re + (size_t)k * 16 + (q - 1) * 4);
        RG[(4 * q + 0) * 1024 + k] = v[0] * gk; RG[(4 * q + 1) * 1024 + k] = v[1] * gk; RG[(4 * q + 2) * 1024 + k] = v[2] * gk; RG[(4 * q + 3) * 1024 + k] = v[3] * gk; }
    __syncthreads();
    const int lane = C.lane, per = (NT + C.G - 1) / C.G, t0 = C.bid * per, t1 = (t0 + per) < NT ? (t0 + per) : NT;
    int* TE = WSP(int, WS_SMALL + SM_TOKE);
    for (int tb = t0 + C.wave * 4; tb < t1; tb += 32) {
        f32x4 xv[4][4];
#pragma unroll
        for (int q = 0; q < 4; ++q) { const int tq = (tb + q < t1) ? tb + q : t1 - 1; const GAS u32x2* xr = (const GAS u32x2*)(WSP(bf16_t, WS_XB) + (size_t)tq * 1024) + lane;
#pragma unroll
            for (int jj = 0; jj < 4; ++jj) { const u32x2 w_ = xr[64 * jj]; xv[q][jj] = (f32x4){bflo(w_.x), bfhi(w_.x), bflo(w_.y), bfhi(w_.y)}; } }
        float lq[4][20]; float sq[4] = {0.f, 0.f, 0.f, 0.f};
#pragma unroll
        for (int q = 0; q < 4; ++q)
#pragma unroll
            for (int j = 0; j < 20; ++j) lq[q][j] = 0.f;
#pragma unroll
        for (int jj = 0; jj < 4; ++jj) { const int k0 = (lane + 64 * jj) * 4;
#pragma unroll
            for (int q = 0; q < 4; ++q) { const f32x4 x = xv[q][jj]; sq[q] += x[0] * x[0] + x[1] * x[1] + x[2] * x[2] + x[3] * x[3]; }
#pragma unroll
            for (int j = 0; j < 20; ++j) { const f32x4 a = *(const LAS f32x4*)(RG + j * 1024 + k0);
#pragma unroll
                for (int q = 0; q < 4; ++q) { const f32x4 x = xv[q][jj]; lq[q][j] += x[0] * a[0] + x[1] * a[1] + x[2] * a[2] + x[3] * a[3]; } } }
        float lg[20]; float ss = 0.f;
#pragma unroll
        for (int q = 0; q < 4; ++q) { const float sv_ = wave_sum(sq[q]); ss = (lane == q) ? sv_ : ss; }
#pragma unroll
        for (int j = 0; j < 20; ++j) { lg[j] = 0.f;
#pragma unroll
            for (int q = 0; q < 4; ++q) { const float v_ = wave_sum(lq[q][j]); lg[j] = (lane == q) ? v_ : lg[j]; } }
        const float s = rsqrtf(ss * (1.0f / 1024.0f) + RMS_EPS);
        const int t = tb + lane;
        if (lane < 4 && t < t1) {
            float gl[4]; int gi = 0;
#pragma unroll
            for (int j = 0; j < 4; ++j) { gl[j] = lg[j] * s + rgb[j]; }
#pragma unroll
            for (int j = 1; j < 4; ++j) if (gl[j] > gl[gi]) gi = j;
            float den = 0.f;
#pragma unroll
            for (int j = 0; j < 4; ++j) den += __expf(gl[j] - gl[gi]);
            const float gw_ = 1.0f / den;
            float el[4];
#pragma unroll
            for (int j = 0; j < 4; ++j) { float v = 0.f;
#pragma unroll
                for (int q = 0; q < 4; ++q) v = (gi == q) ? (lg[4 + q * 4 + j] * s + reb[q * 4 + j]) : v;
                el[j] = v; }
            int e1 = 0;
#pragma unroll
            for (int j = 1; j < 4; ++j) if (el[j] > el[e1]) e1 = j;
            int e2 = (e1 == 0) ? 1 : 0;
#pragma unroll
            for (int j = 0; j < 4; ++j) if (j != e1 && el[j] > el[e2]) e2 = j;
            const float p2 = __expf(el[e2] - el[e1]);
            const float w1 = gw_ / (1.0f + p2), w2 = gw_ * p2 / (1.0f + p2);
            TE[2 * t] = gi * 4 + e1; TE[2 * t + 1] = gi * 4 + e2;
            const int tl = t - t0; lsf[tl] = s; le[2 * tl] = gi * 4 + e1; le[2 * tl + 1] = gi * 4 + e2; lw[2 * tl] = w1; lw[2 * tl + 1] = w2;
            atomicAdd((int*)&cnt[gi * 4 + e1], 1); atomicAdd((int*)&cnt[gi * 4 + e2], 1);
        }
    }
    __syncthreads();
    if (C.tid < 16) { gbase[C.tid] = cnt[C.tid] ? (int)xb_add(WSP(unsigned, WS_CTL) + CW_GC + (16 * l + C.tid) * 32, (unsigned)cnt[C.tid]) : 0; rank[C.tid] = 0; }
    __syncthreads();
    { int* TP = WSP(int, WS_SMALL + SM_TOKPOS); int* EL = WSP(int, WS_ELIST); float* ERS = WSP(float, WS_ERS); float* ERW = WSP(float, WS_ERW);
        for (int x = C.tid; x < 2 * (t1 - t0); x += 512) { const int e = le[x]; const int slot = gbase[e] + atomicAdd((int*)&rank[e], 1);
            EL[e * 16384 + slot] = t0 + (x >> 1); ERS[e * 16384 + slot] = lsf[x >> 1]; ERW[e * 16384 + slot] = lw[x]; TP[2 * t0 + x] = slot; } }
    __syncthreads();
}
__device__ __forceinline__ void moe_info(const Ctx& C, int l, LAS unsigned char* lds, bool publish) {
    LAS int* info = (LAS int*)(lds + LDS_MOEINFO);
    __syncthreads();
    if (C.tid == 0) { int pb = 0; int* ginfo = WSP(int, WS_SMALL + SM_MOEINFO); const unsigned* gc = WSP(unsigned, WS_CTL) + CW_GC + 16 * l * 32;
        for (int e = 0; e < 16; ++e) { const int tot = (int)gc[e * 32]; info[e] = pb; info[32 + e] = pb * 4; info[64 + e] = tot; if (publish && C.bid == 0) ginfo[e] = pb; pb += (tot + 255) >> 8; }
        info[16] = pb; info[32 + 16] = pb * 4; }
    __syncthreads();
}
__device__ __forceinline__ void phase_combine(const Ctx& C, int l) {
    const int gw = C.bid * 8 + C.wave, NGW = C.G * 8, lane = C.lane;
    const int* TP = WSP(int, WS_SMALL + SM_TOKPOS); const int* TE = WSP(int, WS_SMALL + SM_TOKE); const int* ginfo = WSP(int, WS_SMALL + SM_MOEINFO); const bf16_t* yp = WSP(bf16_t, WS_XP); float* ssa = WSP(float, WS_SMALL + SM_SSA); bf16_t* xb = WSP(bf16_t, WS_XB);
    for (int t = gw; t < NT; t += NGW) {
        const int p1 = ginfo[TE[2 * t]] * 256 + TP[2 * t], p2 = ginfo[TE[2 * t + 1]] * 256 + TP[2 * t + 1];
        const GAS u32x2* xi = (const GAS u32x2*)(xb + (size_t)t * 1024) + lane; const GAS u32x2* y1 = (const GAS u32x2*)(yp + (size_t)p1 * 1024) + lane; const GAS u32x2* y2 = (const GAS u32x2*)(yp + (size_t)p2 * 1024) + lane;
        u32x2 xw[4], aw[4], bw[4];
#pragma unroll
        for (int j = 0; j < 4; ++j) { xw[j] = xi[64 * j]; aw[j] = y1[64 * j]; bw[j] = y2[64 * j]; }
        f32x4 v[4]; float s = 0.f;
#pragma unroll
        for (int j = 0; j < 4; ++j) { f32x4 x = (f32x4){bflo(xw[j].x), bfhi(xw[j].x), bflo(xw[j].y), bfhi(xw[j].y)};
            x[0] += bflo(aw[j].x) + bflo(bw[j].x); x[1] += bfhi(aw[j].x) + bfhi(bw[j].x); x[2] += bflo(aw[j].y) + bflo(bw[j].y); x[3] += bfhi(aw[j].y) + bfhi(bw[j].y);
            if (l == 0) { const u32x2 pw = (u32x2){cvt_pk_bf16(x[0], x[1]), cvt_pk_bf16(x[2], x[3])}; xw[j] = pw; x = (f32x4){bflo(pw.x), bfhi(pw.x), bflo(pw.y), bfhi(pw.y)}; }
            v[j] = x; s += x[0] * x[0] + x[1] * x[1] + x[2] * x[2] + x[3] * x[3]; }
        s = wave_sum(s);
        if (l == 1) { const float r = rsqrtf(s * (1.0f / 1024.0f) + RMS_EPS); const f32x4* g = (const f32x4*)CIN(37) + lane; GAS f32x4* o = (GAS f32x4*)(C.out + (size_t)t * 1024) + lane;
#pragma unroll
            for (int j = 0; j < 4; ++j) { const f32x4 gg = g[64 * j]; o[64 * j] = (f32x4){v[j][0] * r * gg[0], v[j][1] * r * gg[1], v[j][2] * r * gg[2], v[j][3] * r * gg[3]}; }
        } else { GAS u32x2* b = (GAS u32x2*)(xb + (size_t)t * 1024) + lane;
#pragma unroll
            for (int j = 0; j < 4; ++j) b[64 * j] = xw[j];
            if (lane == 0) ssa[t] = s; }
    }
}

__device__ __forceinline__ void moe_tail_share(const Ctx& C, LAS unsigned char* lds, int& kb, int& nb) {
    const int T = ((const LAS int*)(lds + LDS_MOEINFO))[32 + 16], rounds = (T + C.G - 1) / C.G, nidle = rounds * C.G - T, first = T - (rounds - 1) * C.G;
    if (rounds >= 2 && nidle >= 96) { kb = (C.bid >= first) ? C.bid - first : -1; nb = nidle; } else { kb = C.bid; nb = C.G; }
}
template <int KIND, int MODE, int K, int lda, int ldb, bool GATHER = false>
__device__ __forceinline__ void run_gemm(const Ctx& C, LAS unsigned char* lds, int l, const char* A, const char* B, int nM, int nN, bool want_ss, const float* e0 = nullptr, const float* e1 = nullptr, const float* e2 = nullptr, const float* e3 = nullptr) {
    Sched<KIND> S; S.linfo = (const LAS int*)(lds + LDS_MOEINFO); S.G = C.G; S.c = C.bid; S.layer = l; S.ws = C.ws; S.A = A; S.B = B; S.nM = nM; S.nN = nN; S.lda = lda; S.ldb = ldb;
    Epi<MODE> E; E.xlds = lds + RING_BYTES; E.layer = l; E.ep[0] = e0; E.ep[1] = e1; E.ep[2] = e2; E.ep[3] = e3; E.out = C.out; E.ws = C.ws; E.want_ss = want_ss;
#ifdef GPROBE
    E.skip = C.skip;
#endif
    pg8::gemm_phase<K, lda, ldb, Epi<MODE>, Sched<KIND>, GATHER>(lds, C.tid, S, E, GATHER ? (const int*)(C.ws + WS_ELIST) : nullptr);
}
__global__ void __launch_bounds__(512, 2) fwd_kernel(Args args) {
    extern __shared__ __attribute__((aligned(16))) unsigned char lds_raw[];
    LAS unsigned char* lds = (LAS unsigned char*)lds_raw;
    Ctx C0;
#ifdef GPROBE
    C0.skip = 0;
#endif
    C0.out = args.out; C0.ws = args.ws; C0.G = gridDim.x; C0.bid = blockIdx.x; C0.tid = threadIdx.x; C0.lane = C0.tid & 63; C0.wave = __builtin_amdgcn_readfirstlane(C0.tid >> 6);
    volatile LAS unsigned* MISC = (volatile LAS unsigned*)(lds + MISC_OFF);
    for (int u = C0.tid; u < (LDS_BYTES - LDSCTL_OFF) / 4; u += 512) ((LAS unsigned*)(lds + LDSCTL_OFF))[u] = 0u;
    __syncthreads();
    XcdBarrier bar; bar.bar = (unsigned*)(C0.ws + WS_CTL) + CW_BAR; bar.x = 0; bar.st = nullptr;
#if MK_ONE_LAUNCH
    bar = xcd_barrier_post((unsigned*)(C0.ws + WS_CTL) + CW_BAR, MISC + 8);
#define GRID_BAR() xcd_barrier(bar)
#else
#define GRID_BAR() do { } while (0)
#endif
    const int lo = args.ph_lo, hi = args.ph_hi;
#ifndef PHMASK
#define PHMASK 0xFFFFFFFu
#endif
#define PH_EN(k) (((PHMASK) >> (k)) & 1u)
#define IN(p) (lo <= (p) && (p) < hi)
#define SEAM(p) do { if ((p) + 1 < hi) GRID_BAR(); } while (0)
#define FRESH() Ctx P = C0; int z_ = 0; { unsigned char* w_ = P.ws; float* o_ = P.out; int wv_ = P.wave, b_ = P.bid, g_ = P.G; asm volatile("" : "+s"(w_), "+s"(o_), "+s"(z_), "+s"(wv_), "+s"(b_), "+s"(g_)); P.bid = b_; P.G = g_; int t_ = wv_ * 64 + (int)__builtin_amdgcn_mbcnt_hi(~0u, __builtin_amdgcn_mbcnt_lo(~0u, 0u)); asm volatile("" : "+v"(t_)); P.ws = w_; P.out = o_; P.tid = t_; P.lane = t_ & 63; P.wave = __builtin_amdgcn_readfirstlane(t_ >> 6); } const Ctx& C = P; const char* wgt = (const char*)(C.ws + WS_WGT); (void)wgt
#define LD(k) P.in[k] = args.in[(k) + z_]
#define AIN(k) (args.in[(k) + z_])
    if (PH_EN(20) && IN(0)) { FRESH(); LD(0); LD(1); LD(25); LD(27); LD(2); LD(3); LD(5); LD(8); LD(10); LD(11); LD(13); LD(21); LD(22); LD(23); LD(24); LD(26); LD(28); phase_prologue(C, lds); SEAM(0); }
#ifdef GPROBE
#define GREP(kind) _Pragma("unroll 1") for (int rep_ = ((kind) == GPROBE ? 0 : 2); rep_ < 3; ++rep_)
#define GSKIP() P.skip = __builtin_amdgcn_readfirstlane((rep_ < 2) ? GPROBE_SKIP : 0)
#else
#define GREP(kind)
#define GSKIP()
#endif
#ifdef XTRA_BARS
#define XBARS() if (IN(pb + 6)) { _Pragma("unroll 1") for (int xb_ = 0; xb_ < XTRA_BARS; ++xb_) GRID_BAR(); }
#else
#define XBARS()
#endif
#ifdef CVPROBE
#define CVREP _Pragma("unroll 1") for (int cv_ = 0; cv_ < CVPROBE; ++cv_)
#else
#define CVREP
#endif
#define LAYER_BODY(l) { const int pb = 1 + (l) * NPH_L; \
        if (PH_EN(0) && IN(pb + 0)) { GREP(GK_S11) { FRESH(); GSKIP(); run_gemm<GK_S11, EM_P1, 1024, 1024, 1024>(C, lds, l, nullptr, nullptr, 0, 0, false); } SEAM(pb + 0); } \
        if (PH_EN(1) && IN(pb + 1)) { FRESH(); LD(4); LD(6); LD(14); phase_prescan(C, l); SEAM(pb + 1); } \
        if (PH_EN(2) && IN(pb + 2)) { FRESH(); run_gemm<GK_X, EM_X, 256, LD1, 256>(C, lds, l, nullptr, nullptr, 0, 0, false, AIN(7), AIN(9), AIN(12), AIN(15)); SEAM(pb + 2); } \
        if (PH_EN(3) && IN(pb + 3)) { FRESH(); LD(4); LD(14); LD(15); LD(16); phase_scanA(C, l, lds); SEAM(pb + 3); } \
        if (PH_EN(4) && IN(pb + 4)) { FRESH(); LD(17); LD(18); phase_scanB(C, l, lds); SEAM(pb + 4); } \
        if (PH_EN(5) && IN(pb + 5)) { GREP(GK_S15) { FRESH(); GSKIP(); run_gemm<GK_S15, EM_S15, 1024, 1024, 1024>(C, lds, l, nullptr, nullptr, 0, 0, false, AIN(20)); } SEAM(pb + 5); } \
        if (PH_EN(6) && IN(pb + 6)) { FRESH(); LD(19); phase_conv(C, l); SEAM(pb + 6); } \
        XBARS() \
        if (PH_EN(7) && IN(pb + 7)) { { FRESH(); run_gemm<GK_DENSE, EM_M1, 1024, 1024, 1024>(C, lds, l, (const char*)(C.ws + WS_STR + ST_CB), wgt + WG_WBB, 64, 4, false); } \
            asm volatile("s_waitcnt vmcnt(0)" ::: "memory"); __builtin_amdgcn_fence(__ATOMIC_RELEASE, "workgroup"); __syncthreads(); __builtin_amdgcn_fence(__ATOMIC_ACQUIRE, "workgroup"); \
            { FRESH(); run_gemm<GK_DENSE, EM_MG, 1024, LD1, 1024>(C, lds, l, (const char*)(C.ws + WS_P1), wgt + WG_WBA, 64, 4, false); } SEAM(pb + 7); } \
        if (PH_EN(9) && IN(pb + 9)) { FRESH(); run_gemm<GK_DENSE, EM_RES, 1024, 1024, 1024>(C, lds, l, (const char*)(C.ws + WS_STR + ST_GA), wgt + WG_WMO, 64, 4, true, (l) == 0 ? AIN(0) : nullptr); SEAM(pb + 9); } \
        if (PH_EN(11) && IN(pb + 11)) { { FRESH(); run_gemm<GK_ATTQ, EM_Q, 1024, 1024, 1024>(C, lds, l, (const char*)(C.ws + WS_XB), wgt + WG_WQ, 64, 4, false); } \
            asm volatile("s_waitcnt vmcnt(0)" ::: "memory"); __builtin_amdgcn_fence(__ATOMIC_RELEASE, "workgroup"); __syncthreads(); __builtin_amdgcn_fence(__ATOMIC_ACQUIRE, "workgroup"); \
            { FRESH(); run_gemm<GK_ATTS, EM_ATTS, 256, 1024, 1024>(C, lds, l, nullptr, nullptr, 0, 0, false); } \
            asm volatile("s_waitcnt vmcnt(0)" ::: "memory"); __builtin_amdgcn_fence(__ATOMIC_RELEASE, "workgroup"); __syncthreads(); __builtin_amdgcn_fence(__ATOMIC_ACQUIRE, "workgroup"); \
            { FRESH(); run_gemm<GK_ATTO, EM_ATTO, 256, 1024, 2048>(C, lds, l, nullptr, nullptr, 0, 0, false); } SEAM(pb + 11); } \
        if (PH_EN(14) && IN(pb + 14)) { FRESH(); run_gemm<GK_DENSE, EM_RES, 1024, 1024, 1024>(C, lds, l, (const char*)(C.ws + WS_P1 + 32 * MiB), wgt + WG_WO, 64, 4, false); SEAM(pb + 14); } \
        if (PH_EN(15) && IN(pb + 15)) { FRESH(); LD(29); LD(30); LD(31); LD(32); LD(33); LD(34); LD(35); LD(36); LD(2); LD(3); LD(5); LD(8); LD(10); LD(11); LD(13); LD(21); LD(22); LD(23); LD(24); LD(26); LD(28); phase_router(C, l, lds); conv_expert_weights(C, l, lds, 1, C.bid, C.G); SEAM(pb + 15); } \
        if (PH_EN(17) && IN(pb + 17)) { { FRESH(); moe_info(C, l, lds, true); run_gemm<GK_MOE1, EM_MOE1, 1024, 1024, 1024, true>(C, lds, l, nullptr, nullptr, 0, 0, false); } \
            { FRESH(); LD(29); LD(36); LD(2); LD(3); LD(5); LD(8); LD(10); LD(11); LD(13); LD(21); LD(22); LD(23); LD(24); LD(26); LD(28); int kb_, nb_; moe_tail_share(C, lds, kb_, nb_); conv_expert_weights(C, l, lds, 2, kb_, nb_); if (l == 0) conv_layer_weights(C, 1, lds, kb_, nb_, 1); } SEAM(pb + 17); } \
        if (PH_EN(18) && IN(pb + 18)) { { FRESH(); moe_info(C, l, lds, false); run_gemm<GK_MOE2, EM_MOE2, 512, 512, 512>(C, lds, l, nullptr, nullptr, 0, 0, false); } \
            if (l == 0) { FRESH(); LD(2); LD(3); LD(5); LD(8); LD(10); LD(11); LD(13); LD(21); LD(22); LD(23); LD(24); LD(26); LD(28); int kb_, nb_; moe_tail_share(C, lds, kb_, nb_); conv_layer_weights(C, 1, lds, kb_, nb_, 2); } SEAM(pb + 18); } \
        if (PH_EN(19) && IN(pb + 19)) { FRESH(); LD(37); phase_combine(C, l); SEAM(pb + 19); } \
    }
    LAYER_BODY(0)
    LAYER_BODY(1)
#undef IN
#undef SEAM
}

extern "C" void kernel_launch(void* const* d_in, const int* in_sizes, int n_in, void* d_out, int out_size, void* d_ws, size_t ws_size, hipStream_t stream) {
    static int grid = 0;
    if (grid == 0) {
        if (n_in != 38 || out_size != NT * DM || ws_size < WS_END) { fprintf(stderr, "kernel_launch: unexpected problem (n_in %d out %d ws %zu, need %zu)\n", n_in, out_size, ws_size, (size_t)WS_END); grid = -1; return; }
        int dev = 0, cus = 0, per_cu = 0;
        if (hipGetDevice(&dev) != hipSuccess || hipDeviceGetAttribute(&cus, hipDeviceAttributeMultiprocessorCount, dev) != hipSuccess) { grid = -1; return; }
        if (hipFuncSetAttribute((const void*)fwd_kernel, hipFuncAttributeMaxDynamicSharedMemorySize, LDS_BYTES) != hipSuccess) { grid = -1; return; }
        if (hipOccupancyMaxActiveBlocksPerMultiprocessor(&per_cu, (const void*)fwd_kernel, 512, LDS_BYTES) != hipSuccess || per_cu < 1) fprintf(stderr, "kernel_launch: occupancy query reports %d\n", per_cu);
        (void)hipGetLastError();
        grid = cus;
    }
    if (grid < 0) return;
    (void)hipMemsetAsync((char*)d_ws + WS_CTL, 0, CTL_ZERO_BYTES, stream);
    Args a{};
    for (int i = 0; i < 38; ++i) a.in[i] = (const float*)d_in[i];
    a.out = (float*)d_out; a.ws = (unsigned char*)d_ws;
#if MK_ONE_LAUNCH
    a.ph_lo = 0; a.ph_hi = NPH;
    hipLaunchKernelGGL(fwd_kernel, dim3(grid), dim3(512), LDS_BYTES, stream, a);
#else
    for (int ph = 0; ph < NPH; ++ph) { a.ph_lo = ph; a.ph_hi = ph + 1; hipLaunchKernelGGL(fwd_kernel, dim3(grid), dim3(512), LDS_BYTES, stream, a); }
#endif
}
```

```cpp
#include <hip/hip_runtime.h>
#include <cstdio>
#include <cstdint>

#ifndef MK_ONE_LAUNCH
#define MK_ONE_LAUNCH 1
#endif

#define LAS __attribute__((address_space(3)))
#define GAS __attribute__((address_space(1)))
typedef unsigned short bf16_t;
typedef short bf16x8 __attribute__((ext_vector_type(8)));
typedef float f32x4 __attribute__((ext_vector_type(4)));
typedef float f32x2 __attribute__((ext_vector_type(2)));
typedef unsigned u32x4 __attribute__((ext_vector_type(4)));
typedef unsigned u32x2 __attribute__((ext_vector_type(2)));

constexpr int NT = 16384, DM = 1024, TT = 2048, NBATCH = 8, NHEAD = 16;
constexpr int LD1 = 3584;
constexpr int INC = 8480;
constexpr int NPH_L = 20, NPH = 1 + 2 * NPH_L;
constexpr float RMS_EPS = 1e-6f, LNX_EPS = 64e-5f;

constexpr size_t MiB = 1u << 20;
constexpr size_t WS_CTL = 0, CTL_ZERO_BYTES = 1 * MiB;
constexpr size_t WS_SMALL = 1 * MiB;
constexpr size_t WS_WGT = 3 * MiB;
constexpr size_t WS_SSBP = 36 * MiB;
constexpr size_t WS_KVB = 38 * MiB;
constexpr size_t WS_XB = 54 * MiB;
constexpr size_t WS_VF = 86 * MiB;
constexpr size_t WS_P1 = 118 * MiB;
constexpr size_t WS_HALO = 230 * MiB;
constexpr size_t WS_STR = 231 * MiB;
constexpr size_t WS_END = 371 * MiB;
constexpr size_t WG_W1A = 0, WG_W1B = 7 * MiB, WG_WX1 = 17 * MiB, WG_WX2 = WG_WX1 + 3 * MiB / 2, WG_WBA = 19 * MiB, WG_WBB = 21 * MiB, WG_WMO = 23 * MiB, WG_WQ = 25 * MiB, WG_WO = 27 * MiB;
constexpr size_t ST_KK = 0, ST_WE = 32 * MiB, ST_AA = 64 * MiB, ST_OG = 96 * MiB;
constexpr size_t ST_U = 0, ST_CB = 32 * MiB, ST_GA = 64 * MiB, ST_GB = 96 * MiB;
constexpr size_t ST_PS = 0, ST_PB = 64 * MiB;
constexpr size_t ST_MN = 0, ST_WKVT = 8 * MiB;
constexpr size_t WS_XP = 118 * MiB, WS_H = 190 * MiB, WS_WE1 = 226 * MiB, WS_WE2 = 258 * MiB;
constexpr int XP_ROWS = 36864;
constexpr size_t SM_SSA = 0, SM_SF = 64 * 1024, SM_TOKE = 128 * 1024, SM_TOKW = 256 * 1024, SM_TOKPOS = 384 * 1024, SM_ROWS = 512 * 1024, SM_ROWW = 672 * 1024,
                 SM_RINV = 832 * 1024, SM_BC = 1088 * 1024, SM_MOEINFO = 1104 * 1024, SM_ROWTOK = 1120 * 1024;
constexpr int WE1_NEARLY = 6, WE1_EARLY = WE1_NEARLY * 512;
constexpr size_t WS_WE1X = 359 * MiB;
constexpr int CW_BAR = 4096, CW_GC = 16384;
constexpr size_t WS_ELIST = 300 * MiB, WS_ERS = 301 * MiB, WS_ERW = 302 * MiB;
constexpr int LDS_MOEINFO = 140288;
constexpr size_t CT_SSB = 64 * 1024;

constexpr int RING_BYTES = 131072, LDS_BYTES = 147456, LDSCTL_OFF = LDS_BYTES - 512, MISC_OFF = LDSCTL_OFF + 320;

typedef __bf16 bf16v2_t __attribute__((ext_vector_type(2)));
__device__ __forceinline__ unsigned cvt_pk_bf16(float lo, float hi) { const f32x2 v = {lo, hi}; const bf16v2_t r = __builtin_convertvector(v, bf16v2_t); return __builtin_bit_cast(unsigned, r); }
__device__ __forceinline__ float bflo(unsigned w) { return __uint_as_float(w << 16); }
__device__ __forceinline__ float bfhi(unsigned w) { return __uint_as_float(w & 0xffff0000u); }
__device__ __forceinline__ float sigm(float x) { return __builtin_amdgcn_rcpf(1.0f + __expf(-x)); }
__device__ __forceinline__ void unpack8(const u32x4 w, float (&f)[8]) { f[0] = bflo(w.x); f[1] = bfhi(w.x); f[2] = bflo(w.y); f[3] = bfhi(w.y); f[4] = bflo(w.z); f[5] = bfhi(w.z); f[6] = bflo(w.w); f[7] = bfhi(w.w); }
__device__ __forceinline__ u32x4 pack8(const float (&f)[8]) { u32x4 w; w.x = cvt_pk_bf16(f[0], f[1]); w.y = cvt_pk_bf16(f[2], f[3]); w.z = cvt_pk_bf16(f[4], f[5]); w.w = cvt_pk_bf16(f[6], f[7]); return w; }
template <int CTRL> __device__ __forceinline__ float dppf(float x) { return __int_as_float(__builtin_amdgcn_update_dpp(0, __float_as_int(x), CTRL, 0xf, 0xf, false)); }
__device__ __forceinline__ float sum8(float x) { x += dppf<0xB1>(x); x += dppf<0x4E>(x); x += dppf<0x141>(x); return x; }
__device__ __forceinline__ float sum16(float x) { x = sum8(x); x += dppf<0x140>(x); return x; }
__device__ __forceinline__ float wave_sum(float v) {
    v = sum16(v);
    v += __int_as_float(__builtin_amdgcn_update_dpp(0, __float_as_int(v), 0x142, 0xa, 0xf, false));
    v += __int_as_float(__builtin_amdgcn_update_dpp(0, __float_as_int(v), 0x143, 0xc, 0xf, false));
    return __int_as_float(__builtin_amdgcn_readlane(__float_as_int(v), 63));
}
__device__ __forceinline__ float wave_max(float v) {
    v = fmaxf(v, dppf<0xB1>(v)); v = fmaxf(v, dppf<0x4E>(v)); v = fmaxf(v, dppf<0x141>(v)); v = fmaxf(v, dppf<0x140>(v));
    const float b = __int_as_float(__builtin_amdgcn_readlane(__float_as_int(v), 16)), c = __int_as_float(__builtin_amdgcn_readlane(__float_as_int(v), 32));
    return fmaxf(fmaxf(__int_as_float(__builtin_amdgcn_readlane(__float_as_int(v), 0)), b), fmaxf(c, __int_as_float(__builtin_amdgcn_readlane(__float_as_int(v), 48))));
}
__device__ __forceinline__ int fresh_lane() { int l; asm volatile("v_mbcnt_lo_u32_b32 %0, -1, 0\n\tv_mbcnt_hi_u32_b32 %0, -1, %0" : "=v"(l)); return l; }
__device__ __forceinline__ void memclob() { asm volatile("" ::: "memory"); }
#define LDS_WAIT() asm volatile("s_waitcnt lgkmcnt(0)" ::: "memory")
#define VM_WAIT() asm volatile("s_waitcnt vmcnt(0)" ::: "memory")

struct Args { const float* in[38]; float* out; unsigned char* ws; int ph_lo, ph_hi; };
struct Ctx {
    const float* in[38];
    float* out;
    unsigned char* ws;
    int G, bid, tid, lane, wave;
#ifdef GPROBE
    int skip;
#endif
};
#define CIN(i) (C.in[(i)])
#define WSP(T, off) ((T*)(C.ws + (off)))

namespace pg8 {
constexpr int BM = 256, BK = 64, HALF = 128, HTB = HALF * BK * 2, STAGE_BYTES = 8 * HTB;
__host__ __device__ __forceinline__ int lds_byte(int r, int c) { const int st = (r >> 4) * 2 + (c >> 5), rr = r & 15, cc = c & 31, ob = rr * 64 + cc * 2; return st * 1024 + (ob ^ (((ob >> 9) & 1) << 5)); }
__host__ __device__ __forceinline__ void stage_rc(int b, int& R, int& Cc) { const int st = b / 1024, sb = b % 1024, swz = sb ^ (((sb >> 9) & 1) << 5); R = (st >> 1) * 16 + swz / 64; Cc = (st & 1) * 32 + (swz % 64) / 2; }
__host__ __device__ __forceinline__ int perm32(int rho) { const int n = rho >> 4, i = rho & 15; return 8 * (i >> 2) + 4 * n + (i & 3); }
struct Unit { int pm, pn, seg, pad, nv, pad2; const char* a; const char* b; };

template <int K, int lda, int ldb, class Epi, class Sched, bool GATHER = false>
__device__ __forceinline__ void gemm_phase(LAS unsigned char* lds, const int tid, const Sched& S, const Epi& E, const int* rowtok = nullptr) {
    const int wid = __builtin_amdgcn_readfirstlane(tid >> 6), lane = tid & 63, wr = wid >> 2, wc = wid & 3, fr = lane & 15, fq = lane >> 4;
    constexpr int nt = K / BK;
    unsigned voffA[2], voffB[2];
#pragma unroll
    for (int i = 0; i < 2; ++i) { int R, Cc; stage_rc(tid * 16 + i * 8192, R, Cc); const int Rb = (R & ~31) + perm32(R & 31);
        voffA[i] = (unsigned)(R * lda + Cc) * 2u; voffB[i] = (unsigned)(Rb * ldb + Cc) * 2u; }
    const size_t kstep = (size_t)(BK * 2);
    const size_t hstepA = (size_t)HALF * lda * 2, hstepB = (size_t)HALF * ldb * 2;
    const unsigned ldsw = (unsigned)wid * 1024u;
    const int aoff = lds_byte(wr * 64 + fr, fq * 8), boff = lds_byte(wc * 32 + fr, fq * 8);
#define PG8_SA(b, h) (((b) * 2 + (h)) * HTB)
#define PG8_SB(b, h) ((4 + (b) * 2 + (h)) * HTB)
#define PG8_STAGE(bufoff, gbase, voff) do { _Pragma("unroll") for (int _i = 0; _i < 2; ++_i) \
        __builtin_amdgcn_global_load_lds((const unsigned*)((const char*)(gbase) + (voff)[_i]), (LAS unsigned*)(lds + (bufoff) + ldsw + _i * 8192), 16, 0, 0); } while (0)
#define PG8_LDA(dst, b, h) do { _Pragma("unroll") for (int m = 0; m < 4; ++m) _Pragma("unroll") for (int k = 0; k < 2; ++k) dst[m][k] = *(const LAS bf16x8*)(lds + PG8_SA(b, h) + aoff + m * 2048 + k * 1024); } while (0)
#define PG8_LDB(dst, b, h) do { _Pragma("unroll") for (int n = 0; n < 2; ++n) _Pragma("unroll") for (int k = 0; k < 2; ++k) dst[n][k] = *(const LAS bf16x8*)(lds + PG8_SB(b, h) + boff + n * 2048 + k * 1024); } while (0)
#define PG8_MMA(ai, bj, At, Bt) do { __builtin_amdgcn_s_setprio(1); _Pragma("unroll") for (int m = 0; m < 4; ++m) _Pragma("unroll") for (int n = 0; n < 2; ++n) _Pragma("unroll") for (int k = 0; k < 2; ++k) \
        acc[ai][bj][m][n] = __builtin_amdgcn_mfma_f32_16x16x32_bf16(Bt[n][k], At[m][k], acc[ai][bj][m][n], 0, 0, 0); __builtin_amdgcn_s_setprio(0); } while (0)
#define PG8_WAIT_V(n) asm volatile("s_waitcnt vmcnt(" #n ")" ::: "memory")
#define PG8_WAIT_L(n) asm volatile("s_waitcnt lgkmcnt(" #n ")" ::: "memory")
#define PG8_WAITQ() do { if constexpr (K < 512 || !Sched::multi) { PG8_WAIT_V(8); break; } const int t_ = __builtin_amdgcn_readfirstlane(t), e_ = __builtin_amdgcn_readfirstlane(eop); asm volatile("s_cmp_lg_u32 %0, 0\n\ts_cbranch_scc1 .Lwn_%=\n\ts_cmp_eq_u32 %1, 0\n\ts_cbranch_scc1 .Lwn_%=\n\ts_cmp_eq_u32 %1, 1\n\ts_cbranch_scc1 .Lwh_%=\n\ts_waitcnt vmcnt(24)\n\ts_branch .Lwe_%=\n.Lwh_%=:\n\ts_waitcnt vmcnt(16)\n\ts_branch .Lwe_%=\n.Lwn_%=:\n\ts_waitcnt vmcnt(8)\n.Lwe_%=:" :: "s"(t_), "s"(e_) : "scc", "memory"); } while (0)
#define PG8_BAR __builtin_amdgcn_s_barrier()
#define PG8_SCHED __builtin_amdgcn_sched_barrier(0)
    Unit cur, nxt; int ui = 0, eop = 0;
    if (!S.next(0, cur)) return;
    f32x4 acc[2][2][4][2];
    bf16x8 At[4][2], B0[2][2], B1[2][2];
    const char* cA = cur.a; const char* cB = cur.b;
    unsigned gA[2][2], gN[2][2], gNN[2][2];
    if constexpr (GATHER) {
#pragma unroll
        for (int h = 0; h < 2; ++h)
#pragma unroll
            for (int i = 0; i < 2; ++i) { int R, Cc; stage_rc(tid * 16 + i * 8192, R, Cc);
                Unit t1, t2; const bool h1 = S.next(1, t1), h2 = S.next(2, t2);
                const int i0 = h * 128 + R;
                const int r0 = i0 < cur.nv ? rowtok[cur.pad + i0] : 0, r1 = h1 ? (i0 < t1.nv ? rowtok[t1.pad + i0] : 0) : r0, r2 = h2 ? (i0 < t2.nv ? rowtok[t2.pad + i0] : 0) : r1;
                gA[h][i] = (unsigned)(r0 * lda + Cc) * 2u; gN[h][i] = (unsigned)(r1 * lda + Cc) * 2u; gNN[h][i] = (unsigned)(r2 * lda + Cc) * 2u; }
    }
#define PG8_STAGE_A(bufoff, gbase, half, nx) do { if constexpr (GATHER) { _Pragma("unroll") for (int _i = 0; _i < 2; ++_i) { const unsigned vo_ = (nx) ? gN[half][_i] : gA[half][_i]; \
            __builtin_amdgcn_global_load_lds((const unsigned*)((const char*)(gbase) + vo_), (LAS unsigned*)(lds + (bufoff) + ldsw + _i * 8192), 16, 0, 0); } } \
        else PG8_STAGE(bufoff, (gbase) + (half) * hstepA, voffA); } while (0)
    PG8_STAGE(PG8_SB(0, 0), cB, voffB); PG8_STAGE(PG8_SB(0, 1), cB + hstepB, voffB); PG8_STAGE_A(PG8_SA(0, 0), cA, 0, false); PG8_STAGE_A(PG8_SA(0, 1), cA, 1, false);
    if (wr == 1) PG8_BAR;
    PG8_WAIT_V(2); PG8_BAR;
    PG8_STAGE(PG8_SB(1, 0), cB + kstep, voffB); PG8_STAGE_A(PG8_SA(1, 0), cA + kstep, 0, false); PG8_STAGE(PG8_SB(1, 1), cB + hstepB + kstep, voffB);
    PG8_WAIT_V(6); PG8_BAR;
#pragma unroll
    for (int a = 0; a < 2; ++a)
#pragma unroll
        for (int b = 0; b < 2; ++b)
#pragma unroll
            for (int m = 0; m < 4; ++m)
#pragma unroll
                for (int n = 0; n < 2; ++n) acc[a][b][m][n] = (f32x4){0.f, 0.f, 0.f, 0.f};
    for (;;) {
        const bool has_next = S.next(ui + 1, nxt);
        const char* nA = has_next ? nxt.a : cA; const char* nB = has_next ? nxt.b : cB;
        for (int t = 0; t < nt; t += 2) {
            const bool last = (t == nt - 2);
            const char* a1 = cA + (size_t)(t + 1) * kstep;
            const char* a2 = last ? nA : cA + (size_t)(t + 2) * kstep; const char* b2 = last ? nB : cB + (size_t)(t + 2) * kstep;
            const char* a3 = a2 + kstep; const char* b3 = b2 + kstep;
            if (last) E.prefetch(cur, wid, lane);
            PG8_LDB(B0, 0, 0); PG8_LDB(B1, 0, 1); PG8_SCHED; PG8_LDA(At, 0, 0); PG8_STAGE_A(PG8_SA(1, 1), a1, 1, false);
            PG8_WAITQ(); PG8_WAIT_L(0); PG8_BAR; PG8_MMA(0, 0, At, B0); PG8_MMA(0, 1, At, B1); PG8_BAR; PG8_SCHED;
            PG8_LDA(At, 0, 1); PG8_STAGE(PG8_SB(0, 0), b2, voffB); PG8_STAGE(PG8_SB(0, 1), b2 + hstepB, voffB); PG8_STAGE_A(PG8_SA(0, 0), a2, 0, last && has_next);
            PG8_WAITQ(); PG8_WAIT_L(0); PG8_BAR; PG8_MMA(1, 0, At, B0); PG8_MMA(1, 1, At, B1); PG8_BAR; PG8_SCHED;
            PG8_LDB(B0, 1, 0); PG8_LDB(B1, 1, 1); PG8_SCHED; PG8_LDA(At, 1, 0); PG8_STAGE_A(PG8_SA(0, 1), a2, 1, last && has_next);
            PG8_WAIT_V(8); PG8_WAIT_L(0); PG8_BAR; PG8_MMA(0, 0, At, B0); PG8_MMA(0, 1, At, B1); PG8_BAR; PG8_SCHED;
            PG8_LDA(At, 1, 1); PG8_STAGE(PG8_SB(1, 0), b3, voffB); PG8_STAGE(PG8_SB(1, 1), b3 + hstepB, voffB); PG8_STAGE_A(PG8_SA(1, 0), a3, 0, last && has_next);
            PG8_WAIT_V(8); PG8_WAIT_L(0); PG8_BAR; PG8_MMA(1, 0, At, B0); PG8_MMA(1, 1, At, B1); PG8_BAR; PG8_SCHED;
        }
        if (wr == 0) PG8_BAR;
#ifdef GPROBE
        if (E.skip != 1)
#endif
        E(acc, cur, wr, wc, fr, fq);
        if (!has_next) break;
        if constexpr (K >= 512 && Sched::multi) eop = __builtin_amdgcn_readfirstlane(E.eops(cur) >> 3);
#pragma unroll
        for (int a = 0; a < 2; ++a)
#pragma unroll
            for (int b = 0; b < 2; ++b)
#pragma unroll
                for (int m = 0; m < 4; ++m)
#pragma unroll
                    for (int n = 0; n < 2; ++n) acc[a][b][m][n] = (f32x4){0.f, 0.f, 0.f, 0.f};
        cur = nxt; cA = nA; cB = nB; ++ui;
        if constexpr (GATHER) {
#pragma unroll
            for (int h = 0; h < 2; ++h)
#pragma unroll
                for (int i = 0; i < 2; ++i) { gA[h][i] = gN[h][i]; gN[h][i] = gNN[h][i]; } }
        if (wr == 1) PG8_BAR;
    }
    PG8_WAIT_V(0);
    PG8_BAR;
#undef PG8_SA
#undef PG8_SB
#undef PG8_STAGE
#undef PG8_STAGE_A
#undef PG8_LDA
#undef PG8_LDB
#undef PG8_MMA
#undef PG8_WAIT_V
#undef PG8_WAIT_L
#undef PG8_WAITQ
#undef PG8_BAR
#undef PG8_SCHED
}
}

#define XB_TMO      128
#define XB_XCNT(j)  (256  + 64 * (j))
#define XB_XSUB(j)  (1280 + 64 * (j))
#define XB_XGEN(j)  (2304 + 64 * (j))
#define XB_TOP      3328
#define XB_TOPGEN   3392
#define XCD_BAR_WORDS 3456
#define XB_SPIN_CAP (1u << 18)
__device__ __forceinline__ unsigned xb_ld(unsigned* p)              { return __hip_atomic_load(p, __ATOMIC_RELAXED, __HIP_MEMORY_SCOPE_AGENT); }
__device__ __forceinline__ unsigned xb_add(unsigned* p, unsigned v) { return __hip_atomic_fetch_add(p, v, __ATOMIC_RELAXED, __HIP_MEMORY_SCOPE_AGENT); }
__device__ __forceinline__ unsigned xb_xcc_id() { return (unsigned)__builtin_amdgcn_s_getreg((3 << 11) | 20) & 0xFu; }
#define XB_SPIN(cond, bar) do { unsigned _sp = 0; while (cond) { __builtin_amdgcn_s_sleep(1); \
    if ((++_sp & 255u) == 0u) { if (xb_ld(&(bar)[XB_TMO])) break; if (_sp > XB_SPIN_CAP) { atomicAdd(&(bar)[XB_TMO], 1u); break; } } } } while (0)
__device__ __forceinline__ void xb_wait_change(unsigned* p, unsigned old, unsigned* bar) {
    unsigned a = xb_ld(p); __builtin_amdgcn_s_sleep(6); unsigned b = xb_ld(p); unsigned sp = 0u;
    for (;;) {
        if (a != old) break;
        a = xb_ld(p);
        if (b != old) break;
        b = xb_ld(p);
        if ((++sp & 127u) == 0u) { if (xb_ld(&bar[XB_TMO])) break; if (sp > (XB_SPIN_CAP >> 1)) { atomicAdd(&bar[XB_TMO], 1u); break; } }
    }
}
struct XcdBarrier { unsigned* bar; unsigned x; volatile LAS unsigned* st; };
__device__ __forceinline__ XcdBarrier xcd_barrier_post(unsigned* bar, volatile LAS unsigned* st) {
    XcdBarrier b; b.bar = bar; b.x = xb_xcc_id(); b.st = st;
    if (threadIdx.x == 0) (void)xb_add(&bar[XB_XCNT(b.x)], 1u);
    return b;
}
__device__ __forceinline__ void xcd_barrier_complete(unsigned* bar, unsigned x, unsigned& nloc, unsigned& nx) {
    const unsigned G = gridDim.x * gridDim.y * gridDim.z;
    unsigned sum, cnt, mine, sp = 0u;
    for (;;) {
        sum = 0u; cnt = 0u; mine = 0u;
#pragma unroll
        for (unsigned j = 0; j < 16; ++j) { const unsigned c = xb_ld(&bar[XB_XCNT(j)]); sum += c; cnt += (c > 0u) ? 1u : 0u; mine = (j == x) ? c : mine; }
        if (sum == G) break;
        __builtin_amdgcn_s_sleep(1);
        if ((++sp & 255u) == 0u) { if (xb_ld(&bar[XB_TMO])) break; if (sp > XB_SPIN_CAP) { atomicAdd(&bar[XB_TMO], 1u); break; } }
    }
    nloc = mine > 0u ? mine : 1u; nx = cnt > 0u ? cnt : 1u;
}
__device__ __forceinline__ void xcd_barrier(const XcdBarrier& b) {
    asm volatile("s_waitcnt vmcnt(0)" ::: "memory");
    __syncthreads();
    if (threadIdx.x == 0) {
        unsigned* bar = b.bar;
        __builtin_amdgcn_s_waitcnt(0);
        unsigned nloc = b.st[0], nx = b.st[1];
        if (nloc == 0u) { xcd_barrier_complete(bar, b.x, nloc, nx); b.st[0] = nloc; b.st[1] = nx; }
        const unsigned old = xb_add(&bar[XB_XSUB(b.x)], 1u);
        const unsigned gen = old / nloc;
        if (old + 1u == (gen + 1u) * nloc) {
            __builtin_amdgcn_fence(__ATOMIC_RELEASE, "agent");
            asm volatile("s_waitcnt vmcnt(0)" ::: "memory");
            const unsigned og = xb_add(&bar[XB_TOP], 1u);
            const unsigned tg = og / nx;
            if (og + 1u == (tg + 1u) * nx) xb_add(&bar[XB_TOPGEN], 1u);
            else xb_wait_change(&bar[XB_TOPGEN], tg, bar);
            xb_add(&bar[XB_XGEN(b.x)], 1u);
            __builtin_amdgcn_fence(__ATOMIC_ACQUIRE, "agent");
            asm volatile("s_waitcnt vmcnt(0)" ::: "memory");
        } else {
            xb_wait_change(&bar[XB_XGEN(b.x)], gen, bar);
            __builtin_amdgcn_fence(__ATOMIC_ACQUIRE, "agent");
            asm volatile("s_waitcnt vmcnt(0)" ::: "memory");
        }
    }
    __syncthreads();
}

enum GemmKind { GK_S11 = 0, GK_X, GK_S15, GK_DENSE, GK_ATTS, GK_ATTO, GK_MOE1, GK_MOE2, GK_ATTQ };
enum EpiMode { EM_P1 = 0, EM_X, EM_S15, EM_M1, EM_MG, EM_RES, EM_Q, EM_ATTS, EM_ATTO, EM_MOE1, EM_MOE2 };

__device__ __forceinline__ void dense_unit(int L, int nM, int nN, int& pm, int& pn) {
    const int nwg = nM * nN; int wgid = L;
    { const int q = nwg / 8, r = nwg % 8, xcd = wgid % 8, off = wgid / 8; wgid = (xcd < r ? xcd * (q + 1) : r * (q + 1) + (xcd - r) * q) + off; }
    const int nig = 8 * nN, gid = wgid / nig, fm = gid * 8, gsz = (nM - fm) < 8 ? (nM - fm) : 8;
    pm = fm + ((wgid % nig) % gsz); pn = (wgid % nig) / gsz;
}

template <int kind> struct Sched {
    static constexpr bool multi = (kind == GK_S11 || kind == GK_X || kind == GK_S15 || kind == GK_MOE1 || kind == GK_MOE2);
    int G, c, layer;
    const char* A; const char* B;
    int nM, nN, lda, ldb;
    const unsigned char* ws; const LAS int* linfo;
    __device__ __forceinline__ bool next(int i, pg8::Unit& u) const {
        const int L = i * G + c;
        u.seg = 0; u.pad = 0; u.nv = 0; u.pad2 = 0;
        if constexpr (kind == GK_S11) {
            const int n0 = 64 * 14;
            if (L < n0) { dense_unit(L, 64, 14, u.pm, u.pn); u.a = (const char*)(ws + WS_XB) + (size_t)u.pm * 256 * 2048; u.b = (const char*)(ws + WS_WGT + WG_W1A) + (size_t)u.pn * 256 * 2048; return true; }
            if (layer != 0) return false;
            const int r = L - n0; if (r >= 128) return false;
            const int sg = r >> 5, idx = r & 31, l2 = sg >> 1;
            const char* mn = (const char*)(ws + WS_STR + ST_MN) + (size_t)l2 * 4 * MiB;
            const char* wk = (const char*)(ws + WS_STR + ST_WKVT) + (size_t)l2 * 4 * MiB;
            u.seg = 1 + sg;
            if ((sg & 1) == 0) { u.pm = idx >> 2; u.pn = idx & 3; u.a = mn + (size_t)u.pm * 256 * 2048; u.b = wk + (size_t)u.pn * 256 * 2048; }
            else { u.pm = idx >> 3; u.pn = idx & 7; u.a = wk + (size_t)(1024 + u.pm * 256) * 2048; u.b = mn + (size_t)u.pn * 256 * 2048; }
            return true; }
        else if constexpr (kind == GK_X) {
            const int nN1 = layer ? 12 : 8, n0 = 64 * nN1;
            const char* p1 = (const char*)(ws + WS_P1);
            if (L < n0) { dense_unit(L, 64, nN1, u.pm, u.pn); u.a = p1 + (size_t)u.pm * 256 * LD1 * 2 + 3072 * 2; u.b = (const char*)(ws + WS_WGT + WG_WX1) + (size_t)u.pn * 256 * 512; return true; }
            const int r = L - n0; if (r >= 256) return false;
            u.seg = 1; dense_unit(r, 64, 4, u.pm, u.pn); u.a = p1 + (size_t)u.pm * 256 * LD1 * 2 + 3328 * 2; u.b = (const char*)(ws + WS_WGT + WG_WX2) + (size_t)u.pn * 256 * 512; return true; }
        else if constexpr (kind == GK_S15) {
            if (L >= 64 * 20) return false;
            dense_unit(L, 64, 20, u.pm, u.pn); u.a = (const char*)(ws + WS_XB) + (size_t)u.pm * 256 * 2048; u.b = (const char*)(ws + WS_WGT + WG_W1B) + (size_t)u.pn * 256 * 2048; return true; }
        else if constexpr (kind == GK_DENSE) {
            if (L >= nM * nN) return false;
            dense_unit(L, nM, nN, u.pm, u.pn); u.a = A + (size_t)u.pm * 256 * lda * 2; u.b = B + (size_t)u.pn * 256 * ldb * 2; return true; }
        else if constexpr (kind == GK_ATTQ) {
            if (L >= 256) return false;
            const int b = L >> 5, h = (L >> 3) & 3, qp = L & 7;
            u.pm = b * 8 + qp; u.pn = h;
            u.a = A + (size_t)u.pm * 256 * lda * 2; u.b = B + (size_t)u.pn * 256 * ldb * 2; return true; }
        else if constexpr (kind == GK_ATTS || kind == GK_ATTO) {
            if (L >= 256) return false;
            const int b = L >> 5, h = (L >> 3) & 3, qp = L & 7;
            u.pm = b * 8 + qp; u.pn = h;
            const char* kvb = (const char*)(ws + WS_KVB) + (size_t)layer * 8 * MiB;
            if (kind == GK_ATTS) { u.a = (const char*)(ws + WS_P1) + ((size_t)u.pm * 256 * 1024 + h * 256) * 2; u.b = kvb + ((size_t)b * 256 * 1024 + h * 256) * 2; }
            else { u.a = (const char*)(ws + WS_STR + ST_PB) + ((size_t)u.pm * 256 * 1024 + h * 256) * 2; u.b = kvb + 4 * MiB + ((size_t)h * 256 * 2048 + b * 256) * 2; }
            return true; }
        else {
            const LAS int* info = linfo;
            if (L >= info[32 + 16]) return false;
            int e = 0;
#pragma unroll 1
            for (int j = 1; j < 16; ++j) if (L >= info[32 + j]) e = j;
            const int loc = L - info[32 + e];
            u.pm = info[e] + (loc >> 2); u.pn = loc & 3; u.seg = e; u.pad = e * 16384 + (loc >> 2) * 256; u.nv = info[64 + e] - (loc >> 2) * 256;
            if (kind == GK_MOE1) { u.a = (const char*)(ws + WS_XB); u.b = (const char*)(ws + ((layer == 1 && e < WE1_NEARLY) ? WS_WE1X : WS_WE1)) + ((size_t)e * 1024 + u.pn * 256) * 2048; }
            else { u.a = (const char*)(ws + WS_H) + (size_t)u.pm * 256 * 1024; u.b = (const char*)(ws + WS_WE2) + ((size_t)e * 1024 + u.pn * 256) * 1024; }
            return true; }
    }
};

#if defined(SC1_EPI)
#define NTST(p, v) do { const u32x4 v_ = (v); asm volatile("global_store_dwordx4 %0, %1, off sc1\n\ts_nop 1" :: "v"(p), "v"(v_) : "memory"); } while (0)
#elif defined(NT_EPI)
#define NTST(p, v) __builtin_nontemporal_store((v), (p))
#else
#define NTST(p, v) (*(p) = (v))
#endif
#define PLST(p, v) (*(p) = (v))
#ifdef SC1_SA
#define ST8SC(p, v) do { const bf16x4 v_ = (v); asm volatile("global_store_dwordx2 %0, %1, off sc1" :: "v"(p), "v"(v_) : "memory"); } while (0)
#else
#define ST8SC(p, v) (*(p) = (v))
#endif
#ifdef GPROBE
#define S15ST(p, v) do { const u32x4 v_ = (v); if (skip != 2) NTST(p, v_); else asm volatile("" :: "v"(v_)); } while (0)
#else
#define S15ST(p, v) NTST(p, v)
#endif
template <int mode> struct Epi {
    int layer;
    const float* ep[4];
    float* out; unsigned char* ws;
    bool want_ss;
#ifdef GPROBE
    int skip;
#endif
    LAS unsigned char* xlds;
    static constexpr bool has_prefetch = (mode == EM_P1 || mode == EM_S15 || mode == EM_MOE2);
    __device__ __forceinline__ void prefetch(const pg8::Unit& u, int wid, int lane) const {
        if constexpr (has_prefetch) {
            const float* src = (mode == EM_MOE2) ? (const float*)(ws + WS_ERW) : (const float*)(ws + WS_SMALL + SM_SSA);
            const int row = (mode == EM_MOE2 ? u.pad : u.pm * 256) + (wid >> 2) * 64 + lane;
            LAS unsigned char* slot = xlds + wid * 1024;
            __builtin_amdgcn_global_load_lds((const unsigned*)(src + row), (LAS unsigned*)slot, 4, 0, 0);
            __builtin_amdgcn_global_load_lds((const unsigned*)(src + row + 128), (LAS unsigned*)(slot + 256), 4, 0, 0);
            if constexpr (mode == EM_S15) {
                const int typ = u.pn < 8 ? 0 : (u.pn - 8) >> 2, cb0 = u.pn < 8 ? 0 : ((u.pn - 8) & 3) * 256;
                const float* gb = ep[0] + layer * 2048 + (typ == 2 ? 1024 : 0);
                __builtin_amdgcn_global_load_lds((const unsigned*)(gb + cb0 + (lane >> 5) * 128 + (wid & 3) * 32 + (lane & 31)), (LAS unsigned*)(slot + 512), 4, 0, 0);
            }
        }
    }
    __device__ __forceinline__ int eops(const pg8::Unit& u) const {
#ifdef GPROBE
        return 0;
#else
        if constexpr (mode == EM_P1 || mode == EM_X || mode == EM_MOE2) return 16;
        else if constexpr (mode == EM_S15) return u.pn < 8 ? 8 : 16;
        else if constexpr (mode == EM_MOE1) return 8;
        else return 0;
#endif
    }
    __device__ __forceinline__ void operator()(const f32x4 (&acc)[2][2][4][2], const pg8::Unit& u, int wr, int wc, int fr_, int fq_) const {
        const int ln_ = fresh_lane(), fr = ln_ & 15, fq = ln_ >> 4;
        const int rbase = u.pm * 256 + wr * 64 + fr;
        const int cl = wc * 32 + 8 * fq;
        const int l = layer;
        const LAS float* SLOT = (const LAS float*)(xlds + (wr * 4 + wc) * 1024);
#define ROWS_LOOP _Pragma("unroll") for (int ai = 0; ai < 2; ++ai) _Pragma("unroll") for (int m = 0; m < 4; (memclob(), ++m))
#define ROW_OF(ai, m) (rbase + (ai) * 128 + (m) * 16)
#define ACC8(bj) const f32x4 v0 = acc[ai][bj][m][0], v1 = acc[ai][bj][m][1]; float v[8] = {v0[0], v0[1], v0[2], v0[3], v1[0], v1[1], v1[2], v1[3]};
#define LOAD8F(dst, p) { const f32x4 t0_ = *(const GAS f32x4*)(p), t1_ = *(const GAS f32x4*)((p) + 4); dst[0] = t0_[0]; dst[1] = t0_[1]; dst[2] = t0_[2]; dst[3] = t0_[3]; dst[4] = t1_[0]; dst[5] = t1_[1]; dst[6] = t1_[2]; dst[7] = t1_[3]; }
        if constexpr (mode == EM_P1) {
            bf16_t* dst; int ld; bool sc = false, halo = false;
            if (u.seg == 0) { dst = (bf16_t*)(ws + WS_P1); ld = LD1; sc = true; halo = true; }
            else { const int sg = u.seg - 1, l2 = sg >> 1; bf16_t* kvb = (bf16_t*)(ws + WS_KVB + (size_t)l2 * 8 * MiB); if ((sg & 1) == 0) { dst = kvb; ld = 1024; } else { dst = kvb + 2 * 1024 * 1024; ld = 2048; } }
            float sv[8];
#pragma unroll
            for (int r8 = 0; r8 < 8; ++r8) sv[r8] = SLOT[(r8 >> 2) * 64 + (r8 & 3) * 16 + fr];
#pragma unroll
            for (int r8 = 0; r8 < 8; ++r8) sv[r8] = sc ? rsqrtf(sv[r8] * (1.0f / 1024.0f) + RMS_EPS) : 1.0f;
            ROWS_LOOP { const int row = ROW_OF(ai, m); const float s = sv[ai * 4 + m];
#pragma unroll
                for (int bj = 0; bj < 2; ++bj) { ACC8(bj)
#pragma unroll
                    for (int j = 0; j < 8; ++j) v[j] *= s;
                    const int col = u.pn * 256 + bj * 128 + cl; const u32x4 w = pack8(v);
                    NTST((GAS u32x4*)(dst + (size_t)row * ld + col), w);
                    if (halo && (row & 255) == 255) NTST((GAS u32x4*)((bf16_t*)(ws + WS_HALO) + (size_t)u.pm * LD1 + col), w);
                    if (halo && (row & 63) == 63 && col < 2048) NTST((GAS u32x4*)((bf16_t*)(ws + 34 * MiB) + (size_t)(row >> 6) * 2048 + col), w); } }
        }
        else if constexpr (mode == EM_X) {
            bf16_t* p1 = (bf16_t*)(ws + WS_P1);
            if (u.seg == 1) { bf16_t* og = (bf16_t*)(ws + WS_STR + ST_OG);
                ROWS_LOOP { const int row = ROW_OF(ai, m);
#pragma unroll
                    for (int bj = 0; bj < 2; ++bj) { ACC8(bj) NTST((GAS u32x4*)(og + (size_t)row * 1024 + u.pn * 256 + bj * 128 + cl), pack8(v)); } }
            } else {
                const int typ = u.pn >> 2, cb0 = (u.pn & 3) * 256;
                const float* bias = typ == 0 ? ep[0] + l * 1024 : (typ == 1 ? ep[1] + l * 1024 : ep[2]);
                const float* ka = ep[3] + l * 1024;
                bf16_t* we = (bf16_t*)(ws + WS_STR + ST_WE); bf16_t* aa = (bf16_t*)(ws + WS_STR + ST_AA); const bf16_t* vf = (const bf16_t*)(ws + WS_VF);
#pragma unroll
                for (int bj = 0; bj < 2; ++bj) { const int c0 = cb0 + bj * 128 + cl;
#pragma unroll
                    for (int ai = 0; ai < 2; ++ai)
#pragma unroll
                        for (int mh = 0; mh < 2; ++mh) {
                            float bb[8]; LOAD8F(bb, bias + c0)
                            if (typ == 0) {
#pragma unroll
                                for (int m2 = 0; m2 < 2; ++m2) { const int m = 2 * mh + m2; const int row = ROW_OF(ai, m); ACC8(bj)
#pragma unroll
                                    for (int j = 0; j < 8; ++j) v[j] = 0.60653065971f * sigm(v[j] + bb[j]);
                                    NTST((GAS u32x4*)(we + (size_t)row * 1024 + c0), pack8(v)); }
                            } else if (typ == 1) {
#pragma unroll
                                for (int m2 = 0; m2 < 2; ++m2) { const int m = 2 * mh + m2; const int row = ROW_OF(ai, m); ACC8(bj)
#pragma unroll
                                    for (int j = 0; j < 8; ++j) v[j] = sigm(v[j] + bb[j]);
                                    NTST((GAS u32x4*)(aa + (size_t)row * 1024 + c0), pack8(v)); }
                            } else {
                                u32x4 vr[2], fr4[2];
#pragma unroll
                                for (int m2 = 0; m2 < 2; ++m2) { vr[m2] = *(const GAS u32x4*)(p1 + (size_t)ROW_OF(ai, 2 * mh + m2) * LD1 + 2048 + c0); fr4[m2] = *(const GAS u32x4*)(vf + (size_t)ROW_OF(ai, 2 * mh + m2) * 1024 + c0); }
#pragma unroll
                                for (int m2 = 0; m2 < 2; ++m2) { const int m = 2 * mh + m2; const int row = ROW_OF(ai, m); ACC8(bj) float vv[8], vff[8]; unpack8(vr[m2], vv); unpack8(fr4[m2], vff);
#pragma unroll
                                    for (int j = 0; j < 8; ++j) vv[j] = vv[j] + (vff[j] - vv[j]) * sigm(v[j] + bb[j]);
                                    NTST((GAS u32x4*)(p1 + (size_t)row * LD1 + 2048 + c0), pack8(vv)); }
                            }
                            memclob();
                        }
                }
            }
        }
        else if constexpr (mode == EM_S15) {
            float sv[8];
#pragma unroll
            for (int r8 = 0; r8 < 8; ++r8) sv[r8] = SLOT[(r8 >> 2) * 64 + (r8 & 3) * 16 + fr];
#pragma unroll
            for (int r8 = 0; r8 < 8; ++r8) sv[r8] = rsqrtf(sv[r8] * (1.0f / 1024.0f) + RMS_EPS);
            if (u.pn < 8) { bf16_t* U = (bf16_t*)(ws + WS_STR + ST_U);
                ROWS_LOOP { const int row = ROW_OF(ai, m); const float s = sv[ai * 4 + m], s2 = s * s;
                    const f32x4 x0 = acc[ai][0][m][0], x1 = acc[ai][0][m][1], c0 = acc[ai][1][m][0], c1 = acc[ai][1][m][1];
                    float v[8] = {x0[0] * c0[0] * s2, x0[1] * c0[1] * s2, x0[2] * c0[2] * s2, x0[3] * c0[3] * s2, x1[0] * c1[0] * s2, x1[1] * c1[1] * s2, x1[2] * c1[2] * s2, x1[3] * c1[3] * s2};
                    S15ST((GAS u32x4*)(U + (size_t)row * 1024 + u.pn * 128 + cl), pack8(v)); }
            } else {
                const int typ = (u.pn - 8) >> 2, cb0 = ((u.pn - 8) & 3) * 256;
                bf16_t* dst = (bf16_t*)(ws + WS_STR + (typ == 0 ? ST_CB : (typ == 1 ? ST_GA : ST_GB)));
#pragma unroll
                for (int bj = 0; bj < 2; ++bj) { const int c0 = cb0 + bj * 128 + cl;
                    float bb[8] = {0, 0, 0, 0, 0, 0, 0, 0};
                    if (typ != 0) { const f32x4 t0_ = *(const LAS f32x4*)(SLOT + 128 + bj * 32 + 8 * fq), t1_ = *(const LAS f32x4*)(SLOT + 128 + bj * 32 + 8 * fq + 4);
                        bb[0] = t0_[0]; bb[1] = t0_[1]; bb[2] = t0_[2]; bb[3] = t0_[3]; bb[4] = t1_[0]; bb[5] = t1_[1]; bb[6] = t1_[2]; bb[7] = t1_[3]; }
                    ROWS_LOOP { const int row = ROW_OF(ai, m); const float s = sv[ai * 4 + m]; ACC8(bj)
#pragma unroll
                        for (int j = 0; j < 8; ++j) { v[j] *= s; if (typ != 0) v[j] = sigm(v[j] + bb[j]); }
                        S15ST((GAS u32x4*)(dst + (size_t)row * 1024 + c0), pack8(v)); } }
            }
        }
        else if constexpr (mode == EM_M1) { bf16_t* gbp = (bf16_t*)(ws + WS_STR + ST_GB);
#pragma unroll
            for (int ai = 0; ai < 2; ++ai) { u32x4 gr[4][2];
#pragma unroll
                for (int m = 0; m < 4; ++m)
#pragma unroll
                    for (int bj = 0; bj < 2; ++bj) gr[m][bj] = *(const GAS u32x4*)(gbp + (size_t)ROW_OF(ai, m) * 1024 + u.pn * 256 + bj * 128 + cl);
#pragma unroll
                for (int m = 0; m < 4; ++m)
#pragma unroll
                    for (int bj = 0; bj < 2; ++bj) { ACC8(bj) float g[8]; unpack8(gr[m][bj], g);
#pragma unroll
                        for (int j = 0; j < 8; ++j) v[j] *= g[j];
                        PLST((GAS u32x4*)(gbp + (size_t)ROW_OF(ai, m) * 1024 + u.pn * 256 + bj * 128 + cl), pack8(v)); }
                memclob(); }
        }
        else if constexpr (mode == EM_MG) { bf16_t* gap = (bf16_t*)(ws + WS_STR + ST_GA); const bf16_t* m1 = (const bf16_t*)(ws + WS_STR + ST_GB);
#pragma unroll
            for (int ai = 0; ai < 2; ++ai)
#pragma unroll
                for (int bj = 0; bj < 2; ++bj) { u32x4 gr[4], mr[4];
#pragma unroll
                    for (int m = 0; m < 4; ++m) { const size_t o = (size_t)ROW_OF(ai, m) * 1024 + u.pn * 256 + bj * 128 + cl; gr[m] = *(const GAS u32x4*)(gap + o); mr[m] = *(const GAS u32x4*)(m1 + o); }
#pragma unroll
                    for (int m = 0; m < 4; ++m) { ACC8(bj) const size_t o = (size_t)ROW_OF(ai, m) * 1024 + u.pn * 256 + bj * 128 + cl; float g[8], mm[8]; unpack8(gr[m], g); unpack8(mr[m], mm);
#pragma unroll
                        for (int j = 0; j < 8; ++j) v[j] = v[j] * g[j] + mm[j];
                        PLST((GAS u32x4*)(gap + o), pack8(v)); }
                    memclob(); }
        }
        else if constexpr (mode == EM_RES) { bf16_t* xb = (bf16_t*)(ws + WS_XB); float* ssb = (float*)(ws + WS_SSBP); const float* xsrc = ep[0];
#pragma unroll
            for (int ai = 0; ai < 2; ++ai) { float ss[4] = {0.f, 0.f, 0.f, 0.f};
#pragma unroll
                for (int bj = 0; bj < 2; ++bj) { f32x4 xa[4], xc[4]; u32x4 xr[4];
                    if (xsrc != nullptr) {
#pragma unroll
                        for (int m = 0; m < 4; ++m) { const GAS f32x4* xp = (const GAS f32x4*)(xsrc + (size_t)ROW_OF(ai, m) * 1024 + u.pn * 256 + bj * 128 + cl); xa[m] = xp[0]; xc[m] = xp[1]; }
                    } else {
#pragma unroll
                        for (int m = 0; m < 4; ++m) xr[m] = *(const GAS u32x4*)(xb + (size_t)ROW_OF(ai, m) * 1024 + u.pn * 256 + bj * 128 + cl);
#pragma unroll
                        for (int m = 0; m < 4; ++m) { float t8[8]; unpack8(xr[m], t8); xa[m] = (f32x4){t8[0], t8[1], t8[2], t8[3]}; xc[m] = (f32x4){t8[4], t8[5], t8[6], t8[7]}; }
                    }
#pragma unroll
                    for (int m = 0; m < 4; ++m) { ACC8(bj) const size_t o = (size_t)ROW_OF(ai, m) * 1024 + u.pn * 256 + bj * 128 + cl;
                        v[0] += xa[m][0]; v[1] += xa[m][1]; v[2] += xa[m][2]; v[3] += xa[m][3]; v[4] += xc[m][0]; v[5] += xc[m][1]; v[6] += xc[m][2]; v[7] += xc[m][3];
                        const u32x4 pw = pack8(v); PLST((GAS u32x4*)(xb + o), pw);
                        float r8[8]; unpack8(pw, r8);
#pragma unroll
                        for (int j = 0; j < 8; ++j) ss[m] += r8[j] * r8[j]; }
                    memclob(); }
                if (want_ss) {
#pragma unroll
                    for (int m = 0; m < 4; ++m) { float s_ = ss[m]; s_ += __shfl_xor(s_, 16); s_ += __shfl_xor(s_, 32); if (fq == 0) *(GAS float*)(ssb + (size_t)ROW_OF(ai, m) * 16 + u.pn * 4 + wc) = s_; } } }
        }
        else if constexpr (mode == EM_Q) { bf16_t* q = (bf16_t*)(ws + WS_P1); const float* ssb = (const float*)(ws + WS_SSBP);
            float sv[8];
#pragma unroll
            for (int ai = 0; ai < 2; ++ai) { f32x4 sp[4][4];
#pragma unroll
                for (int m = 0; m < 4; ++m)
#pragma unroll
                    for (int x = 0; x < 4; ++x) sp[m][x] = *((const GAS f32x4*)(ssb + (size_t)ROW_OF(ai, m) * 16) + x);
#pragma unroll
                for (int m = 0; m < 4; ++m) { const f32x4 s0 = sp[m][0], s1 = sp[m][1], s2 = sp[m][2], s3 = sp[m][3];
                    const float sst = ((s0[0] + s0[1]) + (s0[2] + s0[3])) + ((s1[0] + s1[1]) + (s1[2] + s1[3])) + (((s2[0] + s2[1]) + (s2[2] + s2[3])) + ((s3[0] + s3[1]) + (s3[2] + s3[3])));
                    sv[ai * 4 + m] = rsqrtf(sst * (1.0f / 1024.0f) + RMS_EPS); } }
            ROWS_LOOP { const int row = ROW_OF(ai, m); const float s = sv[ai * 4 + m];
#pragma unroll
                for (int bj = 0; bj < 2; ++bj) { ACC8(bj)
#pragma unroll
                    for (int j = 0; j < 8; ++j) v[j] *= s;
                    PLST((GAS u32x4*)(q + (size_t)row * 1024 + u.pn * 256 + bj * 128 + cl), pack8(v)); } }
        }
        else if constexpr (mode == EM_ATTS) {
            bf16_t* pb = (bf16_t*)(ws + WS_STR + ST_PB); float* rinv = (float*)(ws + WS_SMALL + SM_RINV);
            LAS float* XM = (LAS float*)xlds; LAS float* XS = XM + 1024;
            float mx[8];
#pragma unroll
            for (int r8 = 0; r8 < 8; ++r8) { const int ai = r8 >> 2, m = r8 & 3; float t = -3.0e38f;
#pragma unroll
                for (int bj = 0; bj < 2; ++bj) { const f32x4 a0 = acc[ai][bj][m][0], a1 = acc[ai][bj][m][1]; t = fmaxf(t, fmaxf(fmaxf(fmaxf(a0[0], a0[1]), fmaxf(a0[2], a0[3])), fmaxf(fmaxf(a1[0], a1[1]), fmaxf(a1[2], a1[3])))); }
                t = fmaxf(t, __shfl_xor(t, 16)); t = fmaxf(t, __shfl_xor(t, 32)); mx[r8] = t;
                if (fq == 0) XM[(ai * 128 + wr * 64 + m * 16 + fr) * 4 + wc] = t; }
            asm volatile("s_waitcnt lgkmcnt(0)" ::: "memory"); __builtin_amdgcn_s_barrier(); asm volatile("" ::: "memory");
            float sm[8];
#pragma unroll
            for (int r8 = 0; r8 < 8; ++r8) { const int ai = r8 >> 2, m = r8 & 3; const int rl = ai * 128 + wr * 64 + m * 16 + fr; const f32x4 q4 = *(const LAS f32x4*)(XM + rl * 4);
                const float rm = fmaxf(fmaxf(q4[0], q4[1]), fmaxf(q4[2], q4[3])); float s_ = 0.f; const int row = ROW_OF(ai, m);
#pragma unroll
                for (int bj = 0; bj < 2; ++bj) { const f32x4 a0 = acc[ai][bj][m][0], a1 = acc[ai][bj][m][1];
                    float p[8] = {__expf(a0[0] - rm), __expf(a0[1] - rm), __expf(a0[2] - rm), __expf(a0[3] - rm), __expf(a1[0] - rm), __expf(a1[1] - rm), __expf(a1[2] - rm), __expf(a1[3] - rm)};
                    const u32x4 w = pack8(p); float pr[8]; unpack8(w, pr);
#pragma unroll
                    for (int j = 0; j < 8; ++j) s_ += pr[j];
                    PLST((GAS u32x4*)(pb + ((size_t)row * 4 + u.pn) * 256 + bj * 128 + cl), w); }
                s_ += __shfl_xor(s_, 16); s_ += __shfl_xor(s_, 32); sm[r8] = s_;
                if (fq == 0) XS[rl * 4 + wc] = s_; }
            asm volatile("s_waitcnt lgkmcnt(0)" ::: "memory"); __builtin_amdgcn_s_barrier(); asm volatile("" ::: "memory");
            if (wc == 0 && fq == 0) {
#pragma unroll
                for (int r8 = 0; r8 < 8; ++r8) { const int ai = r8 >> 2, m = r8 & 3; const int rl = ai * 128 + wr * 64 + m * 16 + fr; const f32x4 q4 = *(const LAS f32x4*)(XS + rl * 4);
                    *(GAS float*)(rinv + (size_t)ROW_OF(ai, m) * 4 + u.pn) = 1.0f / ((q4[0] + q4[1]) + (q4[2] + q4[3])); } }
            (void)mx; (void)sm;
        }
        else if constexpr (mode == EM_ATTO) { bf16_t* o = (bf16_t*)(ws + WS_P1 + 32 * MiB); const float* rinv = (const float*)(ws + WS_SMALL + SM_RINV);
#pragma unroll
            for (int ai = 0; ai < 2; ++ai) { float sv[4];
#pragma unroll
                for (int m = 0; m < 4; ++m) sv[m] = *(const GAS float*)(rinv + ROW_OF(ai, m) * 4 + u.pn);
#pragma unroll
                for (int m = 0; m < 4; (memclob(), ++m)) { const int row = ROW_OF(ai, m); const float s = sv[m];
#pragma unroll
                    for (int bj = 0; bj < 2; ++bj) { ACC8(bj)
#pragma unroll
                        for (int j = 0; j < 8; ++j) v[j] *= s;
                        PLST((GAS u32x4*)(o + (size_t)row * 1024 + u.pn * 256 + bj * 128 + cl), pack8(v)); } } }
        }
        else if constexpr (mode == EM_MOE1) { bf16_t* H = (bf16_t*)(ws + WS_H); const float* rs = (const float*)(ws + WS_ERS) + u.pad + wr * 64 + fr;
            float sv[8];
#pragma unroll
            for (int r8 = 0; r8 < 8; ++r8) sv[r8] = *(const GAS float*)(rs + (r8 >> 2) * 128 + (r8 & 3) * 16);
            ROWS_LOOP { const int row = ROW_OF(ai, m); const float s = sv[ai * 4 + m];
                const f32x4 g0 = acc[ai][0][m][0], g1 = acc[ai][0][m][1], u0 = acc[ai][1][m][0], u1 = acc[ai][1][m][1];
                float g[8] = {g0[0], g0[1], g0[2], g0[3], g1[0], g1[1], g1[2], g1[3]}, uu[8] = {u0[0], u0[1], u0[2], u0[3], u1[0], u1[1], u1[2], u1[3]}, v[8];
#pragma unroll
                for (int j = 0; j < 8; ++j) { const float gg = g[j] * s; v[j] = gg * sigm(gg) * (uu[j] * s); }
                NTST((GAS u32x4*)(H + (size_t)row * 512 + u.pn * 128 + cl), pack8(v)); }
        }
        else if constexpr (mode == EM_MOE2) { bf16_t* Y = (bf16_t*)(ws + WS_XP);
            float sv[8];
#pragma unroll
            for (int r8 = 0; r8 < 8; ++r8) sv[r8] = SLOT[(r8 >> 2) * 64 + (r8 & 3) * 16 + fr];
            ROWS_LOOP { const int row = ROW_OF(ai, m); const float s = sv[ai * 4 + m];
#pragma unroll
                for (int bj = 0; bj < 2; ++bj) { ACC8(bj)
#pragma unroll
                    for (int j = 0; j < 8; ++j) v[j] *= s;
                    NTST((GAS u32x4*)(Y + (size_t)row * 1024 + u.pn * 256 + bj * 128 + cl), pack8(v)); } }
        }
#undef ROWS_LOOP
#undef ROW_OF
#undef ACC8
#undef LOAD8F
    }
};

struct TcvIn { f32x4 v[8]; float g[8]; };
__device__ __forceinline__ void tconv_load(TcvIn& t, const float* src, int src_ld, int col0, const float* gain, float scale, int k0, int n0, int lane) {
    const int r = lane >> 3, c4 = (lane & 7) * 4;
#pragma unroll
    for (int i = 0; i < 8; ++i) t.v[i] = __builtin_nontemporal_load((const f32x4*)(src + (size_t)(k0 + 8 * i + r) * src_ld + col0 + n0 + c4));
#pragma unroll
    for (int i = 0; i < 8; ++i) { float g = scale; if (gain) g *= gain[k0 + 8 * i + r]; t.g[i] = g; }
}
__device__ __forceinline__ void tconv_finish(const TcvIn& t, bf16_t* dst, int dst_ld, int k0, int n0, LAS float* scr, int lane) {
    const int r = lane >> 3, c4 = (lane & 7) * 4;
#pragma unroll
    for (int i = 0; i < 8; ++i) { const int kk = 8 * i + r; const float g = t.g[i];
        LAS float* d = scr + kk * 33 + c4; d[0] = t.v[i][0] * g; d[1] = t.v[i][1] * g; d[2] = t.v[i][2] * g; d[3] = t.v[i][3] * g; }
    LDS_WAIT(); asm volatile("" ::: "memory");
    const int c = lane & 7;
#pragma unroll
    for (int j = 0; j < 4; ++j) { const int n = (lane >> 3) + 8 * j; const LAS float* s = scr + (8 * c) * 33 + n;
        u32x4 o; o.x = cvt_pk_bf16(s[0 * 33], s[1 * 33]); o.y = cvt_pk_bf16(s[2 * 33], s[3 * 33]); o.z = cvt_pk_bf16(s[4 * 33], s[5 * 33]); o.w = cvt_pk_bf16(s[6 * 33], s[7 * 33]);
        *(u32x4*)(dst + (size_t)(n0 + n) * dst_ld + k0 + 8 * c) = o; }
    LDS_WAIT(); asm volatile("" ::: "memory");
}
__device__ __forceinline__ void tconv_item(const float* src, int src_ld, int col0, const float* gain, float scale, bf16_t* dst, int dst_ld, int k0, int n0, LAS float* scr, int lane) {
    TcvIn t; tconv_load(t, src, src_ld, col0, gain, scale, k0, n0, lane); tconv_finish(t, dst, dst_ld, k0, n0, scr, lane);
}
struct Seg { const float* src; const float* gain; bf16_t* dst; int src_ld, col0, ncols, K, dst_ld; float scale; };
constexpr int NSEG_MAX = 40;
__device__ __forceinline__ void conv_layer_weights(const Ctx& C, int l, LAS unsigned char* lds, int kb_ = -2, int nb_ = 0, int part = 0) {
    if (kb_ == -2) { kb_ = C.bid; nb_ = C.G; }
    Seg* tab = (Seg*)((unsigned char*)lds + 122880); int* pre = (int*)((unsigned char*)lds + 122880 + NSEG_MAX * sizeof(Seg)); int* nsegp = pre + NSEG_MAX + 1;
    __syncthreads();
    if (C.tid == 0) {
        int n = 0; int items = 0;
        const float* W = CIN(3) + (size_t)l * 1024 * INC; const float* nm = CIN(2) + l * 1024;
        bf16_t* w1a = WSP(bf16_t, WS_WGT + WG_W1A); bf16_t* w1b = WSP(bf16_t, WS_WGT + WG_W1B);
#define ADDSEG(S_, G_, D_, LD_, C0_, NC_, K_, DLD_, SC_) do { Seg s; s.src = (S_); s.gain = (G_); s.dst = (D_); s.src_ld = (LD_); s.col0 = (C0_); s.ncols = (NC_); s.K = (K_); s.dst_ld = (DLD_); s.scale = (SC_); \
        tab[n] = s; pre[n] = items; items += ((K_) / 64) * ((NC_) / 32); ++n; } while (0)
        ADDSEG(W, nm, w1a, INC, 0, 3072, 1024, 1024, 1.f);
        ADDSEG(W, nm, w1a + 3072 * 1024, INC, 3072, 64, 1024, 1024, 1.f);
        ADDSEG(W, nm, w1a + 3136 * 1024, INC, 3136, 64, 1024, 1024, 1.f);
        ADDSEG(W, nm, w1a + 3328 * 1024, INC, 3200, 160, 1024, 1024, 1.f);
        if (l == 1) ADDSEG(CIN(5), nm, w1a + 3200 * 1024, 32, 0, 32, 1024, 1024, 1.f);
        for (int q = 0; q < 8; ++q) { ADDSEG(W, nm, w1b + (size_t)(256 * q) * 1024, INC, 3360 + 128 * q, 128, 1024, 1024, 1.f); ADDSEG(W, nm, w1b + (size_t)(256 * q + 128) * 1024, INC, 3360 + 2048 + 128 * q, 128, 1024, 1024, 1.f); }
        ADDSEG(W, nm, w1b + (size_t)2048 * 1024, INC, 3360 + 1024, 1024, 1024, 1024, 1.f);
        ADDSEG(W, nm, w1b + (size_t)3072 * 1024, INC, 6432, 1024, 1024, 1024, 1.f);
        ADDSEG(W, nm, w1b + (size_t)4096 * 1024, INC, 7456, 1024, 1024, 1024, 1.f);
        ADDSEG(CIN(21) + (size_t)l * 1048576, nullptr, WSP(bf16_t, WS_WGT + WG_WBA), 1024, 0, 1024, 1024, 1024, 1.f);
        ADDSEG(CIN(22) + (size_t)l * 1048576, nullptr, WSP(bf16_t, WS_WGT + WG_WBB), 1024, 0, 1024, 1024, 1024, 1.f);
        ADDSEG(CIN(23) + (size_t)l * 1048576, nullptr, WSP(bf16_t, WS_WGT + WG_WMO), 1024, 0, 1024, 1024, 1024, 1.f);
        ADDSEG(CIN(26) + (size_t)l * 1048576, CIN(24) + l * 1024, WSP(bf16_t, WS_WGT + WG_WQ), 1024, 0, 1024, 1024, 1024, 0.0625f);
        ADDSEG(CIN(28) + (size_t)l * 1048576, nullptr, WSP(bf16_t, WS_WGT + WG_WO), 1024, 0, 1024, 1024, 1024, 1.f);
#undef ADDSEG
        pre[n] = items; *nsegp = n;
    }
    __syncthreads();
    const int nseg = *nsegp, total = pre[nseg];
    LAS float* scr = (LAS float*)(lds + C.wave * 8704);
    const int gw = kb_ * 8 + C.wave, NGW = nb_ * 8;
    const int it_lo = (part == 2) ? total / 2 : 0, it_hi = (part == 1) ? total / 2 : total;
    if (kb_ >= 0) for (int it = it_lo + gw; it < it_hi; it += NGW) {
        int s = 0;
        for (int j = 1; j < nseg; ++j) if (it >= pre[j]) s = j;
        const Seg sg = tab[s]; const int r = it - pre[s], nblk = sg.ncols / 32, kb = r / nblk, nb = r % nblk;
        tconv_item(sg.src, sg.src_ld, sg.col0, sg.gain, sg.scale, sg.dst, sg.dst_ld, 64 * kb, 32 * nb, scr, C.lane);
    }
    if (kb_ < 0 || part == 1) return;
    const int gt = kb_ * 512 + C.tid, NGT = nb_ * 512;
    { bf16_t* w1a = WSP(bf16_t, WS_WGT + WG_W1A); const int z0 = (l == 1) ? 3232 : 3200;
        const int nz = (3328 - z0) + 96;
        for (int i = gt; i < nz * 128; i += NGT) { const int rr = i / 128, cc = i % 128; const int row = rr < (3328 - z0) ? z0 + rr : 3488 + (rr - (3328 - z0)); *(u32x4*)(w1a + (size_t)row * 1024 + cc * 8) = (u32x4){0u, 0u, 0u, 0u}; } }
    { bf16_t* wx1 = WSP(bf16_t, WS_WGT + WG_WX1); const float* du = CIN(8) + (size_t)l * 64 * 1024; const float* au = CIN(10) + (size_t)l * 64 * 1024; const float* vu = CIN(13);
        for (int i = gt; i < 3072 * 32; i += NGT) { const int kg = i / 3072, n = i - kg * 3072, typ = n >> 10, nn = n & 1023, k0 = kg * 8;
            const float* sp = nullptr;
            if (typ == 0) { if (k0 < 64) sp = du + (size_t)k0 * 1024 + nn; } else if (typ == 1) { if (k0 >= 64 && k0 < 128) sp = au + (size_t)(k0 - 64) * 1024 + nn; } else { if (l == 1 && k0 >= 128 && k0 < 160) sp = vu + (size_t)(k0 - 128) * 1024 + nn; }
            u32x4 o = (u32x4){0u, 0u, 0u, 0u};
            if (sp != nullptr) { float v[8];
#pragma unroll
                for (int j = 0; j < 8; ++j) v[j] = *(const GAS float*)(sp + j * 1024);
                o = pack8(v); }
            *(GAS u32x4*)(wx1 + (size_t)n * 256 + k0) = o; }
        bf16_t* wx2 = WSP(bf16_t, WS_WGT + WG_WX2); const float* gu = CIN(11) + (size_t)l * 160 * 1024;
        for (int i = gt; i < 1024 * 32; i += NGT) { const int kg = i >> 10, n = i & 1023, k0 = kg * 8;
            u32x4 o = (u32x4){0u, 0u, 0u, 0u};
            if (k0 < 160) { float v[8];
#pragma unroll
                for (int j = 0; j < 8; ++j) v[j] = *(const GAS float*)(gu + (size_t)(k0 + j) * 1024 + n);
                o = pack8(v); }
            *(GAS u32x4*)(wx2 + (size_t)n * 256 + k0) = o; } }
}
__device__ __forceinline__ void conv_expert_weights(const Ctx& C, int l, LAS unsigned char* lds, int which, int kb_, int nb_, int it_lo = 0, int it_hi = 1 << 30) {
    LAS float* scr = (LAS float*)(lds + C.wave * 8704);
    const int gw = kb_ * 8 + C.wave, NGW = nb_ * 8;
    const float* nf = CIN(29) + l * 1024;
    const int per_e = (which == 1) ? 512 : 256;
    if (it_hi > 16 * per_e) it_hi = 16 * per_e;
    struct EItem { const float* src; const float* gain; bf16_t* dst; int src_ld, col0, dst_ld, k0, n0; };
    auto decode = [&](int it, EItem& x) {
        const int e = it / per_e, r = (it % per_e) + (which == 1 ? 0 : 512);
        if (r < 512) { const int kb = r >> 5, nb = r & 31, n0 = 32 * nb, q = n0 >> 8, within = n0 & 255, wh = within >> 7, hid = q * 128 + (within & 127);
            x.src = (wh ? CIN(35) : CIN(34)) + ((size_t)l * 16 + e) * 1024 * 512; x.src_ld = 512; x.col0 = hid; x.gain = nf;
            x.dst = ((l == 1 && e < WE1_NEARLY) ? WSP(bf16_t, WS_WE1X) : WSP(bf16_t, WS_WE1)) + ((size_t)e * 1024 + n0) * 1024; x.dst_ld = 1024; x.k0 = 64 * kb; x.n0 = 0;
        } else { const int r2 = r - 512, kb = r2 >> 5, nb = r2 & 31;
            x.src = CIN(36) + ((size_t)l * 16 + e) * 512 * 1024; x.src_ld = 1024; x.col0 = 0; x.gain = nullptr;
            x.dst = WSP(bf16_t, WS_WE2) + (size_t)e * 1024 * 512; x.dst_ld = 512; x.k0 = 64 * kb; x.n0 = 32 * nb; } };
    if (kb_ >= 0) for (int it = it_lo + gw; it < it_hi; it += 2 * NGW) {
        EItem a, b2; TcvIn ta, tb; const bool hb = (it + NGW < it_hi);
        decode(it, a); tconv_load(ta, a.src, a.src_ld, a.col0, a.gain, 1.f, a.k0, a.n0, C.lane);
        if (hb) { decode(it + NGW, b2); tconv_load(tb, b2.src, b2.src_ld, b2.col0, b2.gain, 1.f, b2.k0, b2.n0, C.lane); }
        tconv_finish(ta, a.dst, a.dst_ld, a.k0, a.n0, scr, C.lane);
        if (hb) tconv_finish(tb, b2.dst, b2.dst_ld, b2.k0, b2.n0, scr, C.lane);
    }
}
__device__ __forceinline__ void phase_prologue(const Ctx& C, LAS unsigned char* lds) {
    const int gw = C.bid * 8 + C.wave, NGW = C.G * 8, lane = C.lane;
    float* ssa = WSP(float, WS_SMALL + SM_SSA); bf16_t* xb = WSP(bf16_t, WS_XB);
    for (int m = gw; m < NT; m += NGW) {
        const f32x4* xr = (const f32x4*)(CIN(0) + (size_t)m * 1024) + lane; u32x2* b = (u32x2*)(xb + (size_t)m * 1024) + lane;
        float s = 0.f;
#pragma unroll
        for (int j = 0; j < 4; ++j) { const f32x4 v = __builtin_nontemporal_load(xr + 64 * j); s += v[0] * v[0] + v[1] * v[1] + v[2] * v[2] + v[3] * v[3]; b[64 * j] = (u32x2){cvt_pk_bf16(v[0], v[1]), cvt_pk_bf16(v[2], v[3])}; }
        s = wave_sum(s); if (lane == 0) ssa[m] = s;
    }
    for (int m = gw; m < 2048; m += NGW) {
        const f32x4* xr = (const f32x4*)(CIN(1) + (size_t)m * 1024) + lane; f32x4 v[4]; float s = 0.f;
#pragma unroll
        for (int j = 0; j < 4; ++j) { v[j] = xr[64 * j]; s += v[j][0] * v[j][0] + v[j][1] * v[j][1] + v[j][2] * v[j][2] + v[j][3] * v[j][3]; }
        s = rsqrtf(wave_sum(s) * (1.0f / 1024.0f) + RMS_EPS);
#pragma unroll
        for (int l = 0; l < 2; ++l) { const f32x4* g = (const f32x4*)(CIN(25) + l * 1024) + lane; u32x2* b = (u32x2*)(WSP(bf16_t, WS_STR + ST_MN) + (size_t)l * 2048 * 1024 + (size_t)m * 1024) + lane;
#pragma unroll
            for (int j = 0; j < 4; ++j) { const f32x4 gg = g[64 * j]; b[64 * j] = (u32x2){cvt_pk_bf16(v[j][0] * s * gg[0], v[j][1] * s * gg[1]), cvt_pk_bf16(v[j][2] * s * gg[2], v[j][3] * s * gg[3])}; } }
    }
    { LAS float* scr = (LAS float*)(lds + C.wave * 8704);
        for (int it = gw; it < 2 * 16 * 64; it += NGW) { const int l = it >> 10, r = it & 1023, kb = r >> 6, nb = r & 63;
            tconv_item(CIN(27) + (size_t)l * 1024 * 2048, 2048, 0, nullptr, 1.f, WSP(bf16_t, WS_STR + ST_WKVT) + (size_t)l * 2048 * 1024, 1024, 64 * kb, 32 * nb, scr, lane); } }
    conv_layer_weights(C, 0, lds);
}
__device__ __forceinline__ void phase_prescan(const Ctx& C, int l) {
    const int lane = C.lane, rg = lane >> 3, cg = lane & 7;
    bf16_t* p1 = WSP(bf16_t, WS_P1); const bf16_t* halo = WSP(bf16_t, WS_HALO); bf16_t* VF = WSP(bf16_t, WS_VF);
    const float* mu_in = CIN(4) + l * 3360; const float* mu_v = CIN(6);
    const int gw = C.bid * 8 + C.wave, NGW = C.G * 8;
    for (int wu = gw; wu < 64 * 24; wu += NGW) {
        const int pm = wu / 24, s = 32 + (wu % 24);
        int act = 0, mui = -1; bool active = true;
        const int c8 = cg * 8;
        if (s < 48) mui = s * 64 + c8;
        else if (s == 48) { act = 1; mui = 3072 + c8; }
        else if (s == 49) { mui = 3136 + c8; }
        else if (s == 50) { if (l == 1 && cg < 4) mui = -2; else active = false; }
        else if (s == 52 || s == 53) { act = 2; mui = 3200 + (s - 52) * 64 + c8; }
        else if (s == 54) { if (cg < 4) { act = 2; mui = 3200 + 128 + c8; } else active = false; }
        else active = false;
        if (!active) continue;
        float mu[8];
        { const float* mp = (mui == -2) ? mu_v + c8 : mu_in + mui; const f32x4 a = *(const GAS f32x4*)mp, b = *(const GAS f32x4*)(mp + 4); mu[0] = a[0]; mu[1] = a[1]; mu[2] = a[2]; mu[3] = a[3]; mu[4] = b[0]; mu[5] = b[1]; mu[6] = b[2]; mu[7] = b[3]; }
        const bool isv = (s < 48);
        const int col = s * 64 + c8, r0 = pm * 256 + rg * 32;
        u32x4 praw;
        if (rg == 0) { if ((pm & 7) == 0) praw = (u32x4){0u, 0u, 0u, 0u}; else praw = *(const GAS u32x4*)(halo + (size_t)(pm - 1) * LD1 + col); }
        else praw = *(const GAS u32x4*)(p1 + (size_t)(r0 - 1) * LD1 + col);
        u32x4 raw[8];
#pragma unroll
        for (int i = 0; i < 8; ++i) raw[i] = *(const GAS u32x4*)(p1 + (size_t)(r0 + i) * LD1 + col);
        asm volatile("s_waitcnt vmcnt(0)" ::: "memory");
        float prev[8]; unpack8(praw, prev);
#pragma unroll 1
        for (int bt = 0; bt < 4; ++bt) {
            u32x4 nxt[8];
            if (bt < 3) {
#pragma unroll
                for (int i = 0; i < 8; ++i) nxt[i] = *(const GAS u32x4*)(p1 + (size_t)(r0 + 8 * (bt + 1) + i) * LD1 + col); }
#pragma unroll
            for (int i = 0; i < 8; ++i) { const int row = r0 + 8 * bt + i; float cur[8], o[8]; unpack8(raw[i], cur);
#pragma unroll
                for (int j = 0; j < 8; ++j) { float v = cur[j] + (prev[j] - cur[j]) * mu[j]; if (act == 1) v = 2.0f * sigm(2.0f * v) - 1.0f; else if (act == 2) v = sigm(v);        o[j] = v; prev[j] = cur[j]; }
                const u32x4 w = pack8(o); *(GAS u32x4*)(p1 + (size_t)row * LD1 + col) = w;
                if (isv && l == 0) *(GAS u32x4*)(VF + (size_t)row * 1024 + (s - 32) * 64 + c8) = w; }
            if (bt < 3) {
#pragma unroll
                for (int i = 0; i < 8; ++i) raw[i] = nxt[i]; }
        }
    }
}
typedef short bf16x4 __attribute__((ext_vector_type(4)));
#define MFMA16(a, b, c) __builtin_amdgcn_mfma_f32_16x16x16bf16_1k((a), (b), (c), 0, 0, 0)
#define MFMA32(a, b, c) __builtin_amdgcn_mfma_f32_16x16x32_bf16((a), (b), (c), 0, 0, 0)
__device__ __forceinline__ bf16x4 pk4(const f32x4 v) { u32x2 w; w.x = cvt_pk_bf16(v[0], v[1]); w.y = cvt_pk_bf16(v[2], v[3]); return __builtin_bit_cast(bf16x4, w); }
__device__ __forceinline__ f32x4 up4(const bf16x4 h) { const u32x2 w = __builtin_bit_cast(u32x2, h); return (f32x4){bflo(w.x), bfhi(w.x), bflo(w.y), bfhi(w.y)}; }
__device__ __forceinline__ f32x4 addI(f32x4 v, int i, int q) {
#pragma unroll
    for (int e = 0; e < 4; ++e) v[e] += (4 * q + e == i) ? 1.0f : 0.0f;
    return v; }
__device__ __forceinline__ void scat8(LAS unsigned char* mat, int row0, int col, const u32x4 p) {
    LAS bf16_t* m = (LAS bf16_t*)mat; const unsigned wv[4] = {p.x, p.y, p.z, p.w};
#pragma unroll
    for (int j = 0; j < 8; ++j) m[(row0 + j) * 72 + col] = (bf16_t)((j & 1) ? (wv[j >> 1] >> 16) : (wv[j >> 1] & 0xffffu)); }
constexpr int SMB = 64 * 144;
enum { M_At = 0, M_Rt, M_Bm, M_Km, M_AtT, M_VT, M_BtT, M_KtT, M_Aab, M_AabT, M_Aak, M_Arb, M_Ark, M_ApT = M_Bm, M_VpT = M_Km };
constexpr size_t WS_BON = 33 * MiB;
constexpr size_t WS_BND = 34 * MiB;
#define SMAT(m) (lds + (m) * SMB)
#define LDS4(p) (*(const LAS bf16x4*)(p))
#define LDS8(p) (*(const LAS bf16x8*)(p))
__device__ __forceinline__ void settle(f32x4& a) { asm volatile("s_nop 7\n\ts_nop 7" : "+v"(a)); }
__device__ __forceinline__ f32x4 tile64(const LAS unsigned char* X, const LAS unsigned char* Y, int mb, int nb, int i, int q, f32x4 acc) {
    acc = MFMA32(LDS8(Y + (16 * nb + i) * 144 + (8 * q) * 2), LDS8(X + (16 * mb + i) * 144 + (8 * q) * 2), acc);
    acc = MFMA32(LDS8(Y + (16 * nb + i) * 144 + (8 * q + 32) * 2), LDS8(X + (16 * mb + i) * 144 + (8 * q + 32) * 2), acc);
    settle(acc);
    return acc; }
#define LBAR() do { asm volatile("s_waitcnt lgkmcnt(0)" ::: "memory"); __builtin_amdgcn_s_barrier(); asm volatile("" ::: "memory"); } while (0)
typedef short s16x4_t __attribute__((ext_vector_type(4)));
#define TR4(X, t0, c0) __builtin_amdgcn_ds_read_tr16_b64_v4i16((LAS s16x4_t*)((X) + ((t0) + 4 * q + (i >> 2)) * 144 + ((c0) + 4 * (i & 3)) * 2))
__device__ __forceinline__ bf16x8 tr8_(const LAS unsigned char* X, int t0, int c0, int i, int q) {
    const LAS unsigned char* p = X + (t0 + 8 * q + (i >> 2)) * 144 + (c0 + 4 * (i & 3)) * 2;
    const s16x4_t a = __builtin_amdgcn_ds_read_tr16_b64_v4i16((LAS s16x4_t*)p), b = __builtin_amdgcn_ds_read_tr16_b64_v4i16((LAS s16x4_t*)(p + 4 * 144));
    return __builtin_shufflevector(a, b, 0, 1, 2, 3, 4, 5, 6, 7);
}
#define TR8(X, t0, c0) tr8_((X), (t0), (c0), i, q)
#define SWZ(r) (((((r) >> 1) & 1) + 2 * ((((r) >> 2) ^ ((r) >> 3)) & 1)) << 1)
__device__ __forceinline__ s16x4_t trs4_(const LAS unsigned char* X, int R, int c0, int i) {
    return __builtin_amdgcn_ds_read_tr16_b64_v4i16((LAS s16x4_t*)(X + R * 128 + ((((c0 >> 3) + ((i & 3) >> 1)) ^ SWZ(R)) << 4) + (i & 1) * 8)); }
#define TRS4(X, t0, c0) trs4_((X), (t0) + 4 * q + (i >> 2), (c0), i)
__device__ __forceinline__ bf16x8 trs8_(const LAS unsigned char* X, int t0, int c0, int i, int q) {
    const int R = t0 + 8 * q + (i >> 2);
    return __builtin_shufflevector(trs4_(X, R, c0, i), trs4_(X, R + 4, c0, i), 0, 1, 2, 3, 4, 5, 6, 7); }
#define TRS8(X, t0, c0) trs8_((X), (t0), (c0), i, q)
#define RD8(X, r0, k0, tr) ((tr) ? TRS8((X), (k0), (r0)) : LDS8((X) + ((r0) + i) * 144 + (8 * q + (k0)) * 2))
__device__ __forceinline__ void phase_scanA(const Ctx& C, int l, LAS unsigned char* lds) {
    const int tid = C.tid, lane = C.lane, w = C.wave, i = lane & 15, q = lane >> 4;
    const int tt = tid >> 3, c8 = (tid & 7) * 8;
    bf16_t* p1 = WSP(bf16_t, WS_P1); bf16_t* WEp = WSP(bf16_t, WS_STR + ST_WE); bf16_t* AAp = WSP(bf16_t, WS_STR + ST_AA); bf16_t* KKp = WSP(bf16_t, WS_STR + ST_KK); float* BON = WSP(float, WS_BON);
    LAS float* LW = (LAS float*)(lds + 8 * SMB); LAS float* W63 = (LAS float*)(lds + 13 * SMB); LAS float* GT = W63 + 64; LAS float* RK = GT + 512; LAS float* CT = RK + 1024;
    const float* rkp = CIN(16) + l * 1024;
    const f32x4 z4 = (f32x4){0.f, 0.f, 0.f, 0.f};
    u32x4 in_r, in_k, in_v, in_we, in_aa, in_rp, in_kp;
    const float* mup = CIN(4) + l * 3360; const float* kkg = CIN(14) + l * 1024; const float* kag = CIN(15) + l * 1024;
    const unsigned offp = (unsigned)(tt * LD1 + c8) * 2u, offs = (unsigned)(tt * 1024 + c8) * 2u;
#define SA_LOAD(uu) do { const int bh_ = (uu) >> 5, c_ = (uu) & 31; const size_t t0_ = (size_t)((bh_ >> 4) * TT + c_ * 64); const int h0_ = (bh_ & 15) * 64; \
        const char* bp_ = (const char*)(p1 + t0_ * LD1 + h0_); const char* bw_ = (const char*)(WEp + t0_ * 1024 + h0_); const char* ba_ = (const char*)(AAp + t0_ * 1024 + h0_); \
        in_r = *(const GAS u32x4*)(bp_ + offp); in_k = *(const GAS u32x4*)(bp_ + 2048 + offp); in_v = *(const GAS u32x4*)(bp_ + 4096 + offp); \
        in_we = *(const GAS u32x4*)(bw_ + offs); in_aa = *(const GAS u32x4*)(ba_ + offs); \
        if (tt == 0) { if (c_ == 0) { in_rp = (u32x4){0u, 0u, 0u, 0u}; in_kp = in_rp; } else { const bf16_t* bq_ = WSP(bf16_t, WS_BND) + ((t0_ - 1) >> 6) * 2048 + h0_ + c8; in_rp = *(const GAS u32x4*)bq_; in_kp = *(const GAS u32x4*)(bq_ + 1024); } } \
        else { in_rp = *(const GAS u32x4*)(bp_ + offp - LD1 * 2); in_kp = *(const GAS u32x4*)(bp_ + 2048 + offp - LD1 * 2); } } while (0)
    constexpr int NU = 4096;
    for (int x = tid; x < 1024; x += 512) { RK[x] = rkp[x]; CT[x] = mup[x]; CT[1024 + x] = mup[1024 + x]; CT[2048 + x] = kkg[x]; CT[3072 + x] = kag[x]; }
    LBAR();
    int u = C.bid;
    if (u < NU) SA_LOAD(u);
    for (; u < NU; u += C.G) {
        const int bh = u >> 5, c = u & 31, b = bh >> 4, h = bh & 15, tok0 = b * TT + c * 64, hc = h * 64;

        float r[8], k[8], we[8], aa[8], kk[8];
        asm volatile("" : "+v"(in_r), "+v"(in_k), "+v"(in_v), "+v"(in_we), "+v"(in_aa), "+v"(in_rp), "+v"(in_kp));
        unpack8(in_r, r); unpack8(in_k, k); unpack8(in_we, we); unpack8(in_aa, aa);
        {
            float rp[8], kp[8]; unpack8(in_rp, rp); unpack8(in_kp, kp);
            float mur[8], muk[8], kkc[8], kac[8];
#pragma unroll
            for (int hh = 0; hh < 2; ++hh) { const f32x4 c0 = *(const LAS f32x4*)(CT + hc + c8 + 4 * hh), c1 = *(const LAS f32x4*)(CT + 1024 + hc + c8 + 4 * hh), c2 = *(const LAS f32x4*)(CT + 2048 + hc + c8 + 4 * hh), c3 = *(const LAS f32x4*)(CT + 3072 + hc + c8 + 4 * hh);
#pragma unroll
                for (int j = 0; j < 4; ++j) { mur[4 * hh + j] = c0[j]; muk[4 * hh + j] = c1[j]; kkc[4 * hh + j] = c2[j]; kac[4 * hh + j] = c3[j]; } }
            float ssq = 0.f;
#pragma unroll
            for (int j = 0; j < 8; ++j) { r[j] = r[j] + (rp[j] - r[j]) * mur[j]; k[j] = k[j] + (kp[j] - k[j]) * muk[j]; kk[j] = k[j] * kkc[j]; ssq += kk[j] * kk[j]; }
            ssq = sum8(ssq);
            const float inv = __builtin_amdgcn_rsqf(fmaxf(ssq, 1e-24f));
#pragma unroll
            for (int j = 0; j < 8; ++j) { kk[j] = kk[j] * inv; k[j] = k[j] * (1.0f + (aa[j] - 1.0f) * kac[j]); }
        }
        const u32x4 vraw = in_v;
        if (u + C.G < NU) SA_LOAD(u + C.G);
#pragma unroll
        for (int j = 0; j < 8; ++j) LW[tt * 68 + c8 + j] = -we[j];
        LBAR();
        { const int g = tid >> 6, kx = tid & 63; float cs_[8]; float run = 0.f;
#pragma unroll
            for (int n = 0; n < 8; ++n) { run += LW[(8 * g + n) * 68 + kx]; cs_[n] = run; }
            GT[g * 64 + kx] = run;
            LBAR();
            float off = 0.f;
#pragma unroll
            for (int gg = 0; gg < 7; ++gg) off += (gg < g) ? GT[gg * 64 + kx] : 0.f;
#pragma unroll
            for (int n = 0; n < 8; ++n) LW[(8 * g + n) * 68 + kx] = cs_[n] + off; }
        LBAR();
        {
            float at[8], rt[8], bm[8], km[8], bt[8], kt[8]; float bon = 0.f, e63[8];
            float Lv[8], Lm[8], Lev[8], rkv[8];
            { const f32x4 a0 = *(const LAS f32x4*)(LW + tt * 68 + c8), a1 = *(const LAS f32x4*)(LW + tt * 68 + c8 + 4), e0 = *(const LAS f32x4*)(LW + 63 * 68 + c8), e1 = *(const LAS f32x4*)(LW + 63 * 68 + c8 + 4);
                const f32x4 r0 = *(const LAS f32x4*)(RK + hc + c8), r1 = *(const LAS f32x4*)(RK + hc + c8 + 4);
                f32x4 m0 = (f32x4){0.f, 0.f, 0.f, 0.f}, m1 = m0; if (tt) { m0 = *(const LAS f32x4*)(LW + (tt - 1) * 68 + c8); m1 = *(const LAS f32x4*)(LW + (tt - 1) * 68 + c8 + 4); }
#pragma unroll
                for (int j = 0; j < 4; ++j) { Lv[j] = a0[j]; Lv[4 + j] = a1[j]; Lev[j] = e0[j]; Lev[4 + j] = e1[j]; Lm[j] = m0[j]; Lm[4 + j] = m1[j]; rkv[j] = r0[j]; rkv[4 + j] = r1[j]; } }
#pragma unroll
            for (int j = 0; j < 8; ++j) {
                const float L = Lv[j], Lm1 = Lm[j], Le = Lev[j];
                const float eL = __expf(L), eLm1 = __expf(Lm1), einv = __builtin_amdgcn_rcpf(eL), eend = __expf(Le) * einv, bv = kk[j] * aa[j];
                at[j] = -kk[j] * eLm1; rt[j] = r[j] * eL; bm[j] = bv * einv; km[j] = k[j] * einv; bt[j] = bv * eend; kt[j] = k[j] * eend;
                bon += r[j] * k[j] * rkv[j]; e63[j] = eL;
            }
            bon = sum8(bon);
            if ((tid & 7) == 0) *(GAS float*)(BON + (size_t)(tok0 + tt) * 16 + h) = bon;
            if (tt == 63) {
#pragma unroll
                for (int j = 0; j < 8; ++j) W63[c8 + j] = e63[j]; }
            *(LAS u32x4*)(SMAT(M_At) + tt * 144 + c8 * 2) = pack8(at); *(LAS u32x4*)(SMAT(M_Rt) + tt * 144 + c8 * 2) = pack8(rt);
            *(LAS u32x4*)(SMAT(M_Bm) + tt * 144 + c8 * 2) = pack8(bm); *(LAS u32x4*)(SMAT(M_Km) + tt * 144 + c8 * 2) = pack8(km);
            { const int so_ = tt * 128 + (((tid & 7) ^ SWZ(tt)) << 4);
                *(LAS u32x4*)(SMAT(M_VT) + so_) = vraw; *(LAS u32x4*)(SMAT(M_BtT) + so_) = pack8(bt); *(LAS u32x4*)(SMAT(M_KtT) + so_) = pack8(kt); }
        }
        LBAR();
        {
            const bool incl = (w >= 4), isK = ((w >> 1) & 1) != 0;
            const LAS unsigned char* X = SMAT(incl ? M_Rt : M_At);
            const LAS unsigned char* Y = SMAT(isK ? M_Km : M_Bm);
            LAS unsigned char* O = SMAT(incl ? (isK ? M_Ark : M_Arb) : (isK ? M_Aak : M_Aab));
#pragma unroll
            for (int rb_ = 0; rb_ < 2; ++rb_) {
                const int tb = (w & 1) ? (1 + rb_) : (3 * rb_);
                const bf16x8 xf0 = LDS8(X + (16 * tb + i) * 144 + (8 * q) * 2), xf1 = LDS8(X + (16 * tb + i) * 144 + (8 * q + 32) * 2);
#pragma unroll
                for (int jb = 0; jb < 4; ++jb) {
                    f32x4 acc = z4;
                    if (jb <= tb) {
                        acc = MFMA32(LDS8(Y + (16 * jb + i) * 144 + (8 * q) * 2), xf0, acc);
                        acc = MFMA32(LDS8(Y + (16 * jb + i) * 144 + (8 * q + 32) * 2), xf1, acc);
                        settle(acc);
                        if (jb == tb) {
#pragma unroll
                            for (int e = 0; e < 4; ++e) { const int jj = 4 * q + e; const bool keep = incl ? (jj <= i) : (jj < i); acc[e] = keep ? acc[e] : 0.f; } }
                    }
                    const bf16x4 pk = pk4(acc);
                    *(LAS bf16x4*)(O + (16 * tb + i) * 144 + (16 * jb + 4 * q) * 2) = pk;
                    if (!incl && !isK && jb == tb) { const u32x2 pw = __builtin_bit_cast(u32x2, pk); LAS bf16_t* T = (LAS bf16_t*)SMAT(M_AabT);
                        T[(16 * jb + 4 * q + 0) * 72 + 16 * tb + i] = (bf16_t)(pw.x & 0xffffu); T[(16 * jb + 4 * q + 1) * 72 + 16 * tb + i] = (bf16_t)(pw.x >> 16);
                        T[(16 * jb + 4 * q + 2) * 72 + 16 * tb + i] = (bf16_t)(pw.y & 0xffffu); T[(16 * jb + 4 * q + 3) * 72 + 16 * tb + i] = (bf16_t)(pw.y >> 16); }
                }
            }
        }
        LBAR();
        {
            const int cs = 16 * (w & 3); const bool isA = (w < 4);
            f32x4 rhs[4];
            if (isA) {
                const int I = w;
                const bf16x4 nt_ = LDS4(SMAT(M_Aab) + (16 * I + i) * 144 + (16 * I + 4 * q) * 2);
                const bf16x4 nn_ = LDS4(SMAT(M_AabT) + (16 * I + i) * 144 + (16 * I + 4 * q) * 2);
                const bf16x4 e2n = pk4(MFMA16(nt_, nn_, z4)), e2t = pk4(MFMA16(nn_, nt_, z4));
                const bf16x4 e4n = pk4(MFMA16(e2t, e2n, z4)), e4t = pk4(MFMA16(e2n, e2t, z4));
                const f32x4 e8n = MFMA16(e4t, e4n, z4);
                const bf16x4 g2 = pk4(MFMA16(pk4(addI(up4(e4t), i, q)), pk4(addI(e8n, i, q)), z4));
                const bf16x4 g1t = pk4(MFMA16(pk4(addI(up4(e2n), i, q)), pk4(addI(up4(nt_), i, q)), z4));
                *(LAS bf16x4*)(SMAT(M_AabT) + (16 * I + i) * 144 + (16 * ((I + 1) & 3) + 4 * q) * 2) = pk4(MFMA16(g2, g1t, z4));
#pragma unroll
                for (int I2 = 0; I2 < 4; ++I2) rhs[I2] = up4(TR4(SMAT(M_At), 16 * I2, cs));
            } else {
#pragma unroll
                for (int I2 = 0; I2 < 4; ++I2) { f32x4 acc = z4;
#pragma unroll
                    for (int J = 0; J <= I2; ++J) acc = MFMA16(LDS4(SMAT(M_Aak) + (16 * I2 + i) * 144 + (16 * J + 4 * q) * 2), TRS4(SMAT(M_VT), 16 * J, cs), acc);
                    rhs[I2] = acc; }
            }
            LBAR();
            bf16x4 Xb[4];
            LAS unsigned char* XO = SMAT(isA ? M_ApT : M_VpT);
#pragma unroll
            for (int I = 0; I < 4; ++I) {
                f32x4 acc = rhs[I];
#pragma unroll
                for (int J = 0; J < I; ++J) acc = MFMA16(LDS4(SMAT(M_Aab) + (16 * I + i) * 144 + (16 * J + 4 * q) * 2), Xb[J], acc);
                const bf16x4 tal = LDS4(SMAT(M_AabT) + (16 * I + i) * 144 + (16 * ((I + 1) & 3) + 4 * q) * 2);
                Xb[I] = pk4(MFMA16(tal, pk4(acc), z4));
                *(LAS bf16x4*)(XO + (cs + i) * 144 + (16 * I + 4 * q) * 2) = Xb[I];
            }
        }
        LBAR();
#pragma unroll
        for (int ps_ = 0; ps_ < 2; ++ps_) {
            const int mat = 2 * (w >> 2) + ps_;
            const LAS unsigned char* X1 = SMAT(mat == 0 ? M_BtT : (mat == 2 ? M_Arb : M_VpT));
            const LAS unsigned char* Y1 = SMAT(mat == 0 ? M_ApT : (mat == 1 ? M_BtT : (mat == 2 ? M_ApT : M_Arb)));
            const LAS unsigned char* X2 = SMAT(M_VT);
            const LAS unsigned char* Y2 = SMAT(mat == 1 ? M_KtT : M_Ark);
            const bool two = (mat == 1) || (mat == 3);
            bf16_t* dst = mat == 0 ? KKp : (mat == 1 ? WEp : (mat == 2 ? AAp : p1 + 1024)); const int ld = (mat == 3) ? LD1 : 1024;
            { const int mb = w & 3;
                const bf16x8 xa0 = RD8(X1, 16 * mb, 0, mat == 0), xa1 = RD8(X1, 16 * mb, 32, mat == 0);
                bf16x8 xb0 = xa0, xb1 = xa1;
                if (two) { xb0 = TRS8(X2, 0, 16 * mb); xb1 = TRS8(X2, 32, 16 * mb); }
#pragma unroll
                for (int nb = 0; nb < 4; ++nb) {
                    f32x4 acc = z4;
                    acc = MFMA32(RD8(Y1, 16 * nb, 0, mat == 1), xa0, acc);
                    acc = MFMA32(RD8(Y1, 16 * nb, 32, mat == 1), xa1, acc);
                    if (two) { acc = MFMA32(RD8(Y2, 16 * nb, 0, mat == 1), xb0, acc); acc = MFMA32(RD8(Y2, 16 * nb, 32, mat == 1), xb1, acc); }
                    settle(acc);
                    if (mat == 0) {
#pragma unroll
                        for (int e = 0; e < 4; ++e) acc[e] += (16 * mb + i == 16 * nb + 4 * q + e) ? W63[16 * mb + i] : 0.f; }
                    else if (mat == 2) { const f32x4 rr = up4(LDS4(SMAT(M_Rt) + (16 * mb + i) * 144 + (16 * nb + 4 * q) * 2)); acc = acc + rr; }
                    ST8SC((GAS bf16x4*)(dst + (size_t)(tok0 + 16 * mb + i) * ld + hc + 16 * nb + 4 * q), pk4(acc));
                } }
        }
        LBAR();
    }
#undef SA_LOAD
}
__device__ __forceinline__ void phase_scanB(const Ctx& C, int l, LAS unsigned char* lds) {
    const int tid = C.tid, lane = C.lane, w = C.wave, i = lane & 15, q = lane >> 4;
    bf16_t* p1 = WSP(bf16_t, WS_P1); const bf16_t* WEp = WSP(bf16_t, WS_STR + ST_WE); const bf16_t* AAp = WSP(bf16_t, WS_STR + ST_AA); const bf16_t* KKp = WSP(bf16_t, WS_STR + ST_KK); const bf16_t* OGp = WSP(bf16_t, WS_STR + ST_OG);
    const float* BON = WSP(float, WS_BON);
    LAS unsigned char* PTm = lds; LAS unsigned char* Rh = lds + SMB; LAS unsigned char* Gm = lds + 2 * SMB; LAS unsigned char* Y0m = lds + 3 * SMB;
    constexpr int PRB = 17408;
    LAS unsigned char* SMALL0 = lds + 4 * SMB;
    LAS float* YX0 = (LAS float*)(lds + 4 * SMB + 3 * PRB);
    const bool loader = (w < 4);
    const int lt = tid & 255;
    const int row0 = lt >> 3, c16 = (lt & 7) * 8;
    const int ptt = lt >> 2, pc = (lt & 3) * 16;
    for (int u = C.bid; u < NBATCH * NHEAD; u += C.G) {
        const int b = u >> 4, h = u & 15, hc = h * 64;
        LAS float* LGB = YX0 + 2 * 4352;
        if (tid < 128) LGB[tid] = (tid < 64 ? CIN(17) : CIN(18))[l * 1024 + hc + (tid & 63)];
        u32x4 sa[8], sb[8];
        const unsigned os0 = (unsigned)(row0 * 1024 + c16) * 2u, os1 = os0 + 32u * 1024u * 2u, op0 = (unsigned)(row0 * LD1 + c16) * 2u, op1 = op0 + 32u * LD1 * 2u;
#define SB_LD(dst, p) asm volatile("global_load_dwordx4 %0, %1, off" : "=v"(dst) : "v"(p) : "memory")
#define SB_ISSUE(cc, S_) do { const size_t t0_ = (size_t)(b * TT + (cc) * 64); \
            const char* bk_ = (const char*)(KKp + t0_ * 1024 + hc); const char* ba_ = (const char*)(AAp + t0_ * 1024 + hc); const char* bw_ = (const char*)(WEp + t0_ * 1024 + hc); const char* bp_ = (const char*)(p1 + t0_ * LD1 + hc); \
            SB_LD(S_[0], bk_ + os0); SB_LD(S_[1], bk_ + os1); SB_LD(S_[2], ba_ + os0); SB_LD(S_[3], ba_ + os1); SB_LD(S_[4], bw_ + os0); SB_LD(S_[5], bw_ + os1); \
            SB_LD(S_[6], bp_ + 2048 + op0); SB_LD(S_[7], bp_ + 2048 + op1); } while (0)
#define SB_STAGE(cc, S_) do { _Pragma("unroll") for (int k2 = 0; k2 < 2; ++k2) { const int r_ = row0 + 32 * k2; \
            *(LAS u32x4*)(PTm + r_ * 144 + c16 * 2) = S_[0 + k2]; *(LAS u32x4*)(Rh + r_ * 144 + c16 * 2) = S_[2 + k2]; *(LAS u32x4*)(Gm + r_ * 144 + c16 * 2) = S_[4 + k2]; *(LAS u32x4*)(Y0m + r_ * 144 + c16 * 2) = S_[6 + k2]; } } while (0)
#define SB_PDMA(cc) do { const size_t tok_ = (size_t)(b * TT + (cc) * 64 + ptt); LAS unsigned char* d_ = SMALL0 + ((cc) % 3) * PRB + (w - 4) * 1024; \
            const char* gv_ = (const char*)(p1 + tok_ * LD1 + 2048 + hc + pc); const char* go_ = (const char*)(OGp + tok_ * 1024 + hc + pc); \
            __builtin_amdgcn_global_load_lds((const unsigned*)gv_, (LAS unsigned*)d_, 16, 0, 0); __builtin_amdgcn_global_load_lds((const unsigned*)(gv_ + 16), (LAS unsigned*)(d_ + 4096), 16, 0, 0); \
            __builtin_amdgcn_global_load_lds((const unsigned*)go_, (LAS unsigned*)(d_ + 8192), 16, 0, 0); __builtin_amdgcn_global_load_lds((const unsigned*)(go_ + 16), (LAS unsigned*)(d_ + 12288), 16, 0, 0); \
            __builtin_amdgcn_global_load_lds((const unsigned*)(BON + tok_ * 16 + h), (LAS unsigned*)(SMALL0 + ((cc) % 3) * PRB + 16384 + (w - 4) * 256), 4, 0, 0); } while (0)
        bf16x4 Sb[4];
#pragma unroll
        for (int cc = 0; cc < 4; ++cc) Sb[cc] = (bf16x4){0, 0, 0, 0};
#define SB_LITER(cc, S_) do { \
        { if ((cc) + 1 < TT / 64) asm volatile("s_waitcnt vmcnt(8)" ::: "memory"); else asm volatile("s_waitcnt vmcnt(0)" ::: "memory");        \
            asm volatile("" : "+v"(S_[0]), "+v"(S_[1]), "+v"(S_[2]), "+v"(S_[3]), "+v"(S_[4]), "+v"(S_[5]), "+v"(S_[6]), "+v"(S_[7]) :: "memory"); \
            SB_STAGE(cc, S_); if ((cc) + 2 < TT / 64) SB_ISSUE((cc) + 2, S_); } \
        LBAR(); \
        { \
            const LAS unsigned char* lb1 = lds + (i * 144 + q * 8); const LAS unsigned char* lb2 = lb1 + w * 2304; \
            LAS float* yb = YX0 + ((cc) & 1) * 4352 + (4 * q * 68 + 16 * w + i); \
            _Pragma("unroll") for (int tb = 0; tb < 4; ++tb) { \
                f32x4 acc = up4(LDS4(lb2 + 3 * SMB + tb * 32)); \
                _Pragma("unroll") for (int cc2 = 0; cc2 < 4; ++cc2) acc = MFMA16(LDS4(lb1 + SMB + tb * 2304 + cc2 * 32), Sb[cc2], acc); \
                _Pragma("unroll") for (int e = 0; e < 4; ++e) yb[(16 * tb + e) * 68] = acc[e]; if (tb & 1) memclob(); } \
            bf16x4 Sn[4]; \
            _Pragma("unroll") for (int cp = 0; cp < 4; ++cp) { \
                f32x4 acc = up4(LDS4(lb2 + 2 * SMB + cp * 32)); \
                _Pragma("unroll") for (int cc2 = 0; cc2 < 4; ++cc2) acc = MFMA16(LDS4(lb1 + cp * 2304 + cc2 * 32), Sb[cc2], acc); \
                Sn[cp] = pk4(acc); if (cp & 1) memclob(); } \
            _Pragma("unroll") for (int cc2 = 0; cc2 < 4; ++cc2) Sb[cc2] = Sn[cc2]; \
        } \
        LBAR(); } while (0)
#define SB_PITER(cc) do { LBAR(); if ((cc) >= 1) { SB_POST((cc) - 1, (cc)); } asm volatile("s_waitcnt lgkmcnt(0)" ::: "memory");        \
        if ((cc) + 2 < TT / 64) SB_PDMA((cc) + 2); LBAR(); } while (0)
#define SB_POST(pcn, it_) do { const LAS float* Yx = YX0 + ((pcn) & 1) * 4352; const LAS unsigned char* sm_ = SMALL0 + ((pcn) % 3) * PRB; \
            if ((it_) >= 3 && (it_) < TT / 64 - 2) asm volatile("s_waitcnt vmcnt(14)" ::: "memory"); else if ((it_) < 3) asm volatile("s_waitcnt vmcnt(5)" ::: "memory"); else asm volatile("s_waitcnt vmcnt(0)" ::: "memory"); \
            float y[16], s = 0.f; \
            _Pragma("unroll") for (int j4 = 0; j4 < 4; ++j4) { const f32x4 t4 = *(const LAS f32x4*)(Yx + ptt * 68 + pc + 4 * j4); y[4 * j4] = t4[0]; y[4 * j4 + 1] = t4[1]; y[4 * j4 + 2] = t4[2]; y[4 * j4 + 3] = t4[3]; } \
            _Pragma("unroll") for (int j = 0; j < 16; ++j) s += y[j]; \
            s += dppf<0xB1>(s); s += dppf<0x4E>(s); \
            const float mean = s * (1.0f / 64.0f); float s2 = 0.f; \
            _Pragma("unroll") for (int j = 0; j < 16; ++j) { y[j] -= mean; s2 += y[j] * y[j]; } \
            s2 += dppf<0xB1>(s2); s2 += dppf<0x4E>(s2); \
            const float rstd = rsqrtf(s2 * (1.0f / 64.0f) + LNX_EPS), bon = ((const LAS float*)(sm_ + 16384))[lt]; \
            float vv[16], og[16]; \
            unpack8(*(const LAS u32x4*)(sm_ + lt * 16), *(float(*)[8])&vv[0]); unpack8(*(const LAS u32x4*)(sm_ + 4096 + lt * 16), *(float(*)[8])&vv[8]); \
            unpack8(*(const LAS u32x4*)(sm_ + 8192 + lt * 16), *(float(*)[8])&og[0]); unpack8(*(const LAS u32x4*)(sm_ + 12288 + lt * 16), *(float(*)[8])&og[8]); \
            _Pragma("unroll") for (int j = 0; j < 16; ++j) y[j] = (y[j] * rstd * LGB[pc + j] + LGB[64 + pc + j] + bon * vv[j]) * og[j]; \
            const size_t tok = (size_t)(b * TT + (pcn) * 64 + ptt); \
            *(GAS u32x4*)(p1 + tok * LD1 + hc + pc) = pack8(*(float(*)[8])&y[0]); *(GAS u32x4*)(p1 + tok * LD1 + hc + pc + 8) = pack8(*(float(*)[8])&y[8]); } while (0)
        if (loader) { SB_ISSUE(0, sa); SB_ISSUE(1, sb); for (int c = 0; c < TT / 64; c += 2) { SB_LITER(c, sa); SB_LITER(c + 1, sb); } }
        else { SB_PDMA(0); SB_PDMA(1); for (int c = 0; c < TT / 64; c += 2) { SB_PITER(c); SB_PITER(c + 1); } SB_POST(TT / 64 - 1, TT / 64); }
        asm volatile("s_waitcnt vmcnt(0)" ::: "memory");
        LBAR();
    }
#undef SB_POST
#undef SB_LITER
#undef SB_PITER
#undef SB_STAGE
#undef SB_ISSUE
#undef SB_LD
#undef SB_PDMA
}
__device__ __forceinline__ void phase_conv(const Ctx& C, int l) {
    const bf16_t* U = WSP(bf16_t, WS_STR + ST_U); bf16_t* CB = WSP(bf16_t, WS_STR + ST_CB); const float* cw = CIN(19) + l * 3072;
    const int gt = C.bid * 512 + C.tid, NGT = C.G * 512;
    for (int i = gt; i < NT * 128; i += NGT) {
        const int t = i >> 7, c0 = (i & 127) * 8, tl = t & (TT - 1);
        float u0[8], u1[8], u2[8], cb[8], o[8];
        unpack8(*(const u32x4*)(U + (size_t)t * 1024 + c0), u0);
        if (tl >= 1) unpack8(*(const u32x4*)(U + (size_t)(t - 1) * 1024 + c0), u1); else {
#pragma unroll
            for (int j = 0; j < 8; ++j) u1[j] = 0.f; }
        if (tl >= 2) unpack8(*(const u32x4*)(U + (size_t)(t - 2) * 1024 + c0), u2); else {
#pragma unroll
            for (int j = 0; j < 8; ++j) u2[j] = 0.f; }
        u32x4* p = (u32x4*)(CB + (size_t)t * 1024 + c0); unpack8(*p, cb);
#pragma unroll
        for (int j = 0; j < 8; ++j) o[j] = cb[j] * (cw[c0 + j] * u2[j] + cw[1024 + c0 + j] * u1[j] + cw[2048 + c0 + j] * u0[j]);
        *p = pack8(o);
    }
}
__device__ __forceinline__ void phase_router(const Ctx& C, int l, LAS unsigned char* lds) {
    LAS int* cnt = (LAS int*)(lds + 126976); LAS int* gbase = cnt + 16; LAS int* rank = cnt + 32; LAS int* le = cnt + 48; LAS float* lw = (LAS float*)(cnt + 48 + 256); LAS float* lsf = lw + 256;
    LAS float* RG = (LAS float*)lds;
    const float* g = CIN(29) + l * 1024; const float* rg = CIN(30) + (size_t)l * 1024 * 4; const float* rgb = CIN(31) + l * 4; const float* re = CIN(32) + (size_t)l * 1024 * 16; const float* reb = CIN(33) + l * 16;
    __syncthreads();
    if (C.tid < 16) cnt[C.tid] = 0;
    for (int i = C.tid; i < 1024 * 5; i += 512) { const int k = i / 5, q = i % 5; const float gk = g[k];
        const f32x4 v = (q == 0) ? *(const f32x4*)(rg + (size_t)k * 4) : *(const f32x4*)(re + (size_t)k * 16 + (q - 1) * 4);
        RG[(4 * q + 0) * 1024 + k] = v[0] * gk; RG[(4 * q + 1) * 1024 + k] = v[1] * gk; RG[(4 * q + 2) * 1024 + k] = v[2] * gk; RG[(4 * q + 3) * 1024 + k] = v[3] * gk; }
    __syncthreads();
    const int lane = C.lane, per = (NT + C.G - 1) / C.G, t0 = C.bid * per, t1 = (t0 + per) < NT ? (t0 + per) : NT;
    int* TE = WSP(int, WS_SMALL + SM_TOKE);
    for (int tb = t0 + C.wave * 4; tb < t1; tb += 32) {
        f32x4 xv[4][4];
#pragma unroll
        for (int q = 0; q < 4; ++q) { const int tq = (tb + q < t1) ? tb + q : t1 - 1; const GAS u32x2* xr = (const GAS u32x2*)(WSP(bf16_t, WS_XB) + (size_t)tq * 1024) + lane;
#pragma unroll
            for (int jj = 0; jj < 4; ++jj) { const u32x2 w_ = xr[64 * jj]; xv[q][jj] = (f32x4){bflo(w_.x), bfhi(w_.x), bflo(w_.y), bfhi(w_.y)}; } }
        float lq[4][20]; float sq[4] = {0.f, 0.f, 0.f, 0.f};
#pragma unroll
        for (int q = 0; q < 4; ++q)
#pragma unroll
            for (int j = 0; j < 20; ++j) lq[q][j] = 0.f;
#pragma unroll
        for (int jj = 0; jj < 4; ++jj) { const int k0 = (lane + 64 * jj) * 4;
#pragma unroll
            for (int q = 0; q < 4; ++q) { const f32x4 x = xv[q][jj]; sq[q] += x[0] * x[0] + x[1] * x[1] + x[2] * x[2] + x[3] * x[3]; }
#pragma unroll
            for (int j = 0; j < 20; ++j) { const f32x4 a = *(const LAS f32x4*)(RG + j * 1024 + k0);
#pragma unroll
                for (int q = 0; q < 4; ++q) { const f32x4 x = xv[q][jj]; lq[q][j] += x[0] * a[0] + x[1] * a[1] + x[2] * a[2] + x[3] * a[3]; } } }
        float lg[20]; float ss = 0.f;
#pragma unroll
        for (int q = 0; q < 4; ++q) { const float sv_ = wave_sum(sq[q]); ss = (lane == q) ? sv_ : ss; }
#pragma unroll
        for (int j = 0; j < 20; ++j) { lg[j] = 0.f;
#pragma unroll
            for (int q = 0; q < 4; ++q) { const float v_ = wave_sum(lq[q][j]); lg[j] = (lane == q) ? v_ : lg[j]; } }
        const float s = rsqrtf(ss * (1.0f / 1024.0f) + RMS_EPS);
        const int t = tb + lane;
        if (lane < 4 && t < t1) {
            float gl[4]; int gi = 0;
#pragma unroll
            for (int j = 0; j < 4; ++j) { gl[j] = lg[j] * s + rgb[j]; }
#pragma unroll
            for (int j = 1; j < 4; ++j) if (gl[j] > gl[gi]) gi = j;
            float den = 0.f;
#pragma unroll
            for (int j = 0; j < 4; ++j) den += __expf(gl[j] - gl[gi]);
            const float gw_ = 1.0f / den;
            float el[4];
#pragma unroll
            for (int j = 0; j < 4; ++j) { float v = 0.f;
#pragma unroll
                for (int q = 0; q < 4; ++q) v = (gi == q) ? (lg[4 + q * 4 + j] * s + reb[q * 4 + j]) : v;
                el[j] = v; }
            int e1 = 0;
#pragma unroll
            for (int j = 1; j < 4; ++j) if (el[j] > el[e1]) e1 = j;
            int e2 = (e1 == 0) ? 1 : 0;
#pragma unroll
            for (int j = 0; j < 4; ++j) if (j != e1 && el[j] > el[e2]) e2 = j;
            const float p2 = __expf(el[e2] - el[e1]);
            const float w1 = gw_ / (1.0f + p2), w2 = gw_ * p2 / (1.0f + p2);
            TE[2 * t] = gi * 4 + e1; TE[2 * t + 1] = gi * 4 + e2;
            const int tl = t - t0; lsf[tl] = s; le[2 * tl] = gi * 4 + e1; le[2 * tl + 1] = gi * 4 + e2; lw[2 * tl] = w1; lw[2 * tl + 1] = w2;
            atomicAdd((int*)&cnt[gi * 4 + e1], 1); atomicAdd((int*)&cnt[gi * 4 + e2], 1);
        }
    }
    __syncthreads();
    if (C.tid < 16) { gbase[C.tid] = cnt[C.tid] ? (int)xb_add(WSP(unsigned, WS_CTL) + CW_GC + (16 * l + C.tid) * 32, (unsigned)cnt[C.tid]) : 0; rank[C.tid] = 0; }
    __syncthreads();
    { int* TP = WSP(int, WS_SMALL + SM_TOKPOS); int* EL = WSP(int, WS_ELIST); float* ERS = WSP(float, WS_ERS); float* ERW = WSP(float, WS_ERW);
        for (int x = C.tid; x < 2 * (t1 - t0); x += 512) { const int e = le[x]; const int slot = gbase[e] + atomicAdd((int*)&rank[e], 1);
            EL[e * 16384 + slot] = t0 + (x >> 1); ERS[e * 16384 + slot] = lsf[x >> 1]; ERW[e * 16384 + slot] = lw[x]; TP[2 * t0 + x] = slot; } }
    __syncthreads();
}
__device__ __forceinline__ void moe_info(const Ctx& C, int l, LAS unsigned char* lds, bool publish) {
    LAS int* info = (LAS int*)(lds + LDS_MOEINFO);
    __syncthreads();
    if (C.tid == 0) { int pb = 0; int* ginfo = WSP(int, WS_SMALL + SM_MOEINFO); const unsigned* gc = WSP(unsigned, WS_CTL) + CW_GC + 16 * l * 32;
        for (int e = 0; e < 16; ++e) { const int tot = (int)gc[e * 32]; info[e] = pb; info[32 + e] = pb * 4; info[64 + e] = tot; if (publish && C.bid == 0) ginfo[e] = pb; pb += (tot + 255) >> 8; }
        info[16] = pb; info[32 + 16] = pb * 4; }
    __syncthreads();
}
__device__ __forceinline__ void phase_combine(const Ctx& C, int l) {
    const int gw = C.bid * 8 + C.wave, NGW = C.G * 8, lane = C.lane;
    const int* TP = WSP(int, WS_SMALL + SM_TOKPOS); const int* TE = WSP(int, WS_SMALL + SM_TOKE); const int* ginfo = WSP(int, WS_SMALL + SM_MOEINFO); const bf16_t* yp = WSP(bf16_t, WS_XP); float* ssa = WSP(float, WS_SMALL + SM_SSA); bf16_t* xb = WSP(bf16_t, WS_XB);
    for (int t = gw; t < NT; t += NGW) {
        const int p1 = ginfo[TE[2 * t]] * 256 + TP[2 * t], p2 = ginfo[TE[2 * t + 1]] * 256 + TP[2 * t + 1];
        const GAS u32x2* xi = (const GAS u32x2*)(xb + (size_t)t * 1024) + lane; const GAS u32x2* y1 = (const GAS u32x2*)(yp + (size_t)p1 * 1024) + lane; const GAS u32x2* y2 = (const GAS u32x2*)(yp + (size_t)p2 * 1024) + lane;
        u32x2 xw[4], aw[4], bw[4];
#pragma unroll
        for (int j = 0; j < 4; ++j) { xw[j] = xi[64 * j]; aw[j] = __builtin_nontemporal_load(y1 + 64 * j); bw[j] = __builtin_nontemporal_load(y2 + 64 * j); }
        f32x4 v[4]; float s = 0.f;
#pragma unroll
        for (int j = 0; j < 4; ++j) { f32x4 x = (f32x4){bflo(xw[j].x), bfhi(xw[j].x), bflo(xw[j].y), bfhi(xw[j].y)};
            x[0] += bflo(aw[j].x) + bflo(bw[j].x); x[1] += bfhi(aw[j].x) + bfhi(bw[j].x); x[2] += bflo(aw[j].y) + bflo(bw[j].y); x[3] += bfhi(aw[j].y) + bfhi(bw[j].y);
            if (l == 0) { const u32x2 pw = (u32x2){cvt_pk_bf16(x[0], x[1]), cvt_pk_bf16(x[2], x[3])}; xw[j] = pw; x = (f32x4){bflo(pw.x), bfhi(pw.x), bflo(pw.y), bfhi(pw.y)}; }
            v[j] = x; s += x[0] * x[0] + x[1] * x[1] + x[2] * x[2] + x[3] * x[3]; }
        s = wave_sum(s);
        if (l == 1) { const float r = rsqrtf(s * (1.0f / 1024.0f) + RMS_EPS); const f32x4* g = (const f32x4*)CIN(37) + lane; GAS f32x4* o = (GAS f32x4*)(C.out + (size_t)t * 1024) + lane;
#pragma unroll
            for (int j = 0; j < 4; ++j) { const f32x4 gg = g[64 * j]; o[64 * j] = (f32x4){v[j][0] * r * gg[0], v[j][1] * r * gg[1], v[j][2] * r * gg[2], v[j][3] * r * gg[3]}; }
        } else { GAS u32x2* b = (GAS u32x2*)(xb + (size_t)t * 1024) + lane;
#pragma unroll
            for (int j = 0; j < 4; ++j) b[64 * j] = xw[j];
            if (lane == 0) ssa[t] = s; }
    }
}

__device__ __forceinline__ void moe_tail_share(const Ctx& C, LAS unsigned char* lds, int& kb, int& nb) {
    const int T = ((const LAS int*)(lds + LDS_MOEINFO))[32 + 16], rounds = (T + C.G - 1) / C.G, nidle = rounds * C.G - T, first = T - (rounds - 1) * C.G;
    if (rounds >= 2 && nidle >= 96) { kb = (C.bid >= first) ? C.bid - first : -1; nb = nidle; } else { kb = C.bid; nb = C.G; }
}
template <int KIND, int MODE, int K, int lda, int ldb, bool GATHER = false>
__device__ __forceinline__ void run_gemm(const Ctx& C, LAS unsigned char* lds, int l, const char* A, const char* B, int nM, int nN, bool want_ss, const float* e0 = nullptr, const float* e1 = nullptr, const float* e2 = nullptr, const float* e3 = nullptr) {
    Sched<KIND> S; S.linfo = (const LAS int*)(lds + LDS_MOEINFO); S.G = C.G; S.c = C.bid; S.layer = l; S.ws = C.ws; S.A = A; S.B = B; S.nM = nM; S.nN = nN; S.lda = lda; S.ldb = ldb;
    Epi<MODE> E; E.xlds = lds + RING_BYTES; E.layer = l; E.ep[0] = e0; E.ep[1] = e1; E.ep[2] = e2; E.ep[3] = e3; E.out = C.out; E.ws = C.ws; E.want_ss = want_ss;
#ifdef GPROBE
    E.skip = C.skip;
#endif
    pg8::gemm_phase<K, lda, ldb, Epi<MODE>, Sched<KIND>, GATHER>(lds, C.tid, S, E, GATHER ? (const int*)(C.ws + WS_ELIST) : nullptr);
}
__global__ void __launch_bounds__(512, 2) fwd_kernel(Args args) {
    extern __shared__ __attribute__((aligned(16))) unsigned char lds_raw[];
    LAS unsigned char* lds = (LAS unsigned char*)lds_raw;
    Ctx C0;
#ifdef GPROBE
    C0.skip = 0;
#endif
    C0.out = args.out; C0.ws = args.ws; C0.G = gridDim.x; C0.bid = blockIdx.x; C0.tid = threadIdx.x; C0.lane = C0.tid & 63; C0.wave = __builtin_amdgcn_readfirstlane(C0.tid >> 6);
    volatile LAS unsigned* MISC = (volatile LAS unsigned*)(lds + MISC_OFF);
    for (int u = C0.tid; u < (LDS_BYTES - LDSCTL_OFF) / 4; u += 512) ((LAS unsigned*)(lds + LDSCTL_OFF))[u] = 0u;
    __syncthreads();
    XcdBarrier bar; bar.bar = (unsigned*)(C0.ws + WS_CTL) + CW_BAR; bar.x = 0; bar.st = nullptr;
#if MK_ONE_LAUNCH
    bar = xcd_barrier_post((unsigned*)(C0.ws + WS_CTL) + CW_BAR, MISC + 8);
#define GRID_BAR() xcd_barrier(bar)
#else
#define GRID_BAR() do { } while (0)
#endif
    const int lo = args.ph_lo, hi = args.ph_hi;
#ifndef PHMASK
#define PHMASK 0xFFFFFFFu
#endif
#define PH_EN(k) (((PHMASK) >> (k)) & 1u)
#define IN(p) (lo <= (p) && (p) < hi)
#define SEAM(p) do { if ((p) + 1 < hi) GRID_BAR(); } while (0)
#define FRESH() Ctx P = C0; int z_ = 0; { unsigned char* w_ = P.ws; float* o_ = P.out; int wv_ = P.wave, b_ = P.bid, g_ = P.G; asm volatile("" : "+s"(w_), "+s"(o_), "+s"(z_), "+s"(wv_), "+s"(b_), "+s"(g_)); P.bid = b_; P.G = g_; int t_ = wv_ * 64 + (int)__builtin_amdgcn_mbcnt_hi(~0u, __builtin_amdgcn_mbcnt_lo(~0u, 0u)); asm volatile("" : "+v"(t_)); P.ws = w_; P.out = o_; P.tid = t_; P.lane = t_ & 63; P.wave = __builtin_amdgcn_readfirstlane(t_ >> 6); } const Ctx& C = P; const char* wgt = (const char*)(C.ws + WS_WGT); (void)wgt
#define LD(k) P.in[k] = args.in[(k) + z_]
#define AIN(k) (args.in[(k) + z_])
    if (PH_EN(20) && IN(0)) { FRESH(); LD(0); LD(1); LD(25); LD(27); LD(2); LD(3); LD(5); LD(8); LD(10); LD(11); LD(13); LD(21); LD(22); LD(23); LD(24); LD(26); LD(28); phase_prologue(C, lds); SEAM(0); }
#ifdef GPROBE
#define GREP(kind) _Pragma("unroll 1") for (int rep_ = ((kind) == GPROBE ? 0 : 2); rep_ < 3; ++rep_)
#define GSKIP() P.skip = __builtin_amdgcn_readfirstlane((rep_ < 2) ? GPROBE_SKIP : 0)
#else
#define GREP(kind)
#define GSKIP()
#endif
#ifdef XTRA_BARS
#define XBARS() if (IN(pb + 6)) { _Pragma("unroll 1") for (int xb_ = 0; xb_ < XTRA_BARS; ++xb_) GRID_BAR(); }
#else
#define XBARS()
#endif
#ifdef CVPROBE
#define CVREP _Pragma("unroll 1") for (int cv_ = 0; cv_ < CVPROBE; ++cv_)
#else
#define CVREP
#endif
#define LAYER_BODY(l) { const int pb = 1 + (l) * NPH_L; \
        if (PH_EN(0) && IN(pb + 0)) { GREP(GK_S11) { FRESH(); GSKIP(); run_gemm<GK_S11, EM_P1, 1024, 1024, 1024>(C, lds, l, nullptr, nullptr, 0, 0, false); } \
            if (l == 1) { FRESH(); LD(29); LD(34); LD(35); LD(36); const int nt_ = 64 * 14, rd_ = (nt_ + C.G - 1) / C.G, ni_ = rd_ * C.G - nt_, f_ = nt_ - (rd_ - 1) * C.G;        \
                if (ni_ >= 96) conv_expert_weights(C, l, lds, 1, C.bid >= f_ ? C.bid - f_ : -1, ni_, 0, WE1_EARLY); else conv_expert_weights(C, l, lds, 1, C.bid, C.G, 0, WE1_EARLY); } SEAM(pb + 0); } \
        if (PH_EN(1) && IN(pb + 1)) { FRESH(); LD(4); LD(6); LD(14); phase_prescan(C, l); SEAM(pb + 1); } \
        if (PH_EN(2) && IN(pb + 2)) { FRESH(); run_gemm<GK_X, EM_X, 256, LD1, 256>(C, lds, l, nullptr, nullptr, 0, 0, false, AIN(7), AIN(9), AIN(12), AIN(15)); SEAM(pb + 2); } \
        if (PH_EN(3) && IN(pb + 3)) { FRESH(); LD(4); LD(14); LD(15); LD(16); phase_scanA(C, l, lds); SEAM(pb + 3); } \
        if (PH_EN(4) && IN(pb + 4)) { FRESH(); LD(17); LD(18); phase_scanB(C, l, lds); SEAM(pb + 4); } \
        if (PH_EN(5) && IN(pb + 5)) { GREP(GK_S15) { FRESH(); GSKIP(); run_gemm<GK_S15, EM_S15, 1024, 1024, 1024>(C, lds, l, nullptr, nullptr, 0, 0, false, AIN(20)); } SEAM(pb + 5); } \
        if (PH_EN(6) && IN(pb + 6)) { FRESH(); LD(19); phase_conv(C, l); SEAM(pb + 6); } \
        XBARS() \
        if (PH_EN(7) && IN(pb + 7)) { { FRESH(); run_gemm<GK_DENSE, EM_M1, 1024, 1024, 1024>(C, lds, l, (const char*)(C.ws + WS_STR + ST_CB), wgt + WG_WBB, 64, 4, false); } \
            asm volatile("s_waitcnt vmcnt(0)" ::: "memory"); __builtin_amdgcn_fence(__ATOMIC_RELEASE, "workgroup"); __syncthreads(); __builtin_amdgcn_fence(__ATOMIC_ACQUIRE, "workgroup"); \
            { FRESH(); run_gemm<GK_DENSE, EM_MG, 1024, LD1, 1024>(C, lds, l, (const char*)(C.ws + WS_P1), wgt + WG_WBA, 64, 4, false); } SEAM(pb + 7); } \
        if (PH_EN(9) && IN(pb + 9)) { FRESH(); run_gemm<GK_DENSE, EM_RES, 1024, 1024, 1024>(C, lds, l, (const char*)(C.ws + WS_STR + ST_GA), wgt + WG_WMO, 64, 4, true, (l) == 0 ? AIN(0) : nullptr); SEAM(pb + 9); } \
        if (PH_EN(11) && IN(pb + 11)) { { FRESH(); run_gemm<GK_ATTQ, EM_Q, 1024, 1024, 1024>(C, lds, l, (const char*)(C.ws + WS_XB), wgt + WG_WQ, 64, 4, false); } \
            asm volatile("s_waitcnt vmcnt(0)" ::: "memory"); __builtin_amdgcn_fence(__ATOMIC_RELEASE, "workgroup"); __syncthreads(); __builtin_amdgcn_fence(__ATOMIC_ACQUIRE, "workgroup"); \
            { FRESH(); run_gemm<GK_ATTS, EM_ATTS, 256, 1024, 1024>(C, lds, l, nullptr, nullptr, 0, 0, false); } \
            asm volatile("s_waitcnt vmcnt(0)" ::: "memory"); __builtin_amdgcn_fence(__ATOMIC_RELEASE, "workgroup"); __syncthreads(); __builtin_amdgcn_fence(__ATOMIC_ACQUIRE, "workgroup"); \
            { FRESH(); run_gemm<GK_ATTO, EM_ATTO, 256, 1024, 2048>(C, lds, l, nullptr, nullptr, 0, 0, false); } SEAM(pb + 11); } \
        if (PH_EN(14) && IN(pb + 14)) { FRESH(); run_gemm<GK_DENSE, EM_RES, 1024, 1024, 1024>(C, lds, l, (const char*)(C.ws + WS_P1 + 32 * MiB), wgt + WG_WO, 64, 4, false); SEAM(pb + 14); } \
        if (PH_EN(15) && IN(pb + 15)) { FRESH(); LD(29); LD(30); LD(31); LD(32); LD(33); LD(34); LD(35); LD(36); LD(2); LD(3); LD(5); LD(8); LD(10); LD(11); LD(13); LD(21); LD(22); LD(23); LD(24); LD(26); LD(28); phase_router(C, l, lds); conv_expert_weights(C, l, lds, 1, C.bid, C.G, l == 1 ? WE1_EARLY : 0); SEAM(pb + 15); } \
        if (PH_EN(17) && IN(pb + 17)) { { FRESH(); moe_info(C, l, lds, true); run_gemm<GK_MOE1, EM_MOE1, 1024, 1024, 1024, true>(C, lds, l, nullptr, nullptr, 0, 0, false); } \
            { FRESH(); LD(29); LD(36); LD(2); LD(3); LD(5); LD(8); LD(10); LD(11); LD(13); LD(21); LD(22); LD(23); LD(24); LD(26); LD(28); int kb_, nb_; moe_tail_share(C, lds, kb_, nb_); conv_expert_weights(C, l, lds, 2, kb_, nb_); if (l == 0) conv_layer_weights(C, 1, lds, kb_, nb_, 1); } SEAM(pb + 17); } \
        if (PH_EN(18) && IN(pb + 18)) { { FRESH(); moe_info(C, l, lds, false); run_gemm<GK_MOE2, EM_MOE2, 512, 512, 512>(C, lds, l, nullptr, nullptr, 0, 0, false); } \
            if (l == 0) { FRESH(); LD(2); LD(3); LD(5); LD(8); LD(10); LD(11); LD(13); LD(21); LD(22); LD(23); LD(24); LD(26); LD(28); int kb_, nb_; moe_tail_share(C, lds, kb_, nb_); conv_layer_weights(C, 1, lds, kb_, nb_, 2); } SEAM(pb + 18); } \
        if (PH_EN(19) && IN(pb + 19)) { FRESH(); LD(37); phase_combine(C, l); SEAM(pb + 19); } \
    }
    LAYER_BODY(0)
    LAYER_BODY(1)
#undef IN
#undef SEAM
}

extern "C" void kernel_launch(void* const* d_in, const int* in_sizes, int n_in, void* d_out, int out_size, void* d_ws, size_t ws_size, hipStream_t stream) {
    static int grid = 0;
    if (grid == 0) {
        if (n_in != 38 || out_size != NT * DM || ws_size < WS_END) { fprintf(stderr, "kernel_launch: unexpected problem (n_in %d out %d ws %zu, need %zu)\n", n_in, out_size, ws_size, (size_t)WS_END); grid = -1; return; }
        int dev = 0, cus = 0, per_cu = 0;
        if (hipGetDevice(&dev) != hipSuccess || hipDeviceGetAttribute(&cus, hipDeviceAttributeMultiprocessorCount, dev) != hipSuccess) { grid = -1; return; }
        if (hipFuncSetAttribute((const void*)fwd_kernel, hipFuncAttributeMaxDynamicSharedMemorySize, LDS_BYTES) != hipSuccess) { grid = -1; return; }
        if (hipOccupancyMaxActiveBlocksPerMultiprocessor(&per_cu, (const void*)fwd_kernel, 512, LDS_BYTES) != hipSuccess || per_cu < 1) fprintf(stderr, "kernel_launch: occupancy query reports %d\n", per_cu);
        (void)hipGetLastError();
        grid = cus;
    }
    if (grid < 0) return;
    (void)hipMemsetAsync((char*)d_ws + WS_CTL, 0, CTL_ZERO_BYTES, stream);
    Args a{};
    for (int i = 0; i < 38; ++i) a.in[i] = (const float*)d_in[i];
    a.out = (float*)d_out; a.ws = (unsigned char*)d_ws;
#if MK_ONE_LAUNCH
    a.ph_lo = 0; a.ph_hi = NPH;
    hipLaunchKernelGGL(fwd_kernel, dim3(grid), dim3(512), LDS_BYTES, stream, a);
#else
    for (int ph = 0; ph < NPH; ++ph) { a.ph_lo = ph; a.ph_hi = ph + 1; hipLaunchKernelGGL(fwd_kernel, dim3(grid), dim3(512), LDS_BYTES, stream, a); }
#endif
}
```
